# Optimizing an MI355X kernel written in HIP

```python
import math
import jax
import jax.numpy as jnp
from jax import lax
import numpy as np

D_MODEL = 2048
BATCH = 4
SEQ = 2048
DEPTH = 1

GRID_W = 64
CTX_LEN = 256
EXPAND = 2
MIX_WIDTH = EXPAND * D_MODEL
SSD_WIDTH = MIX_WIDTH // 2
CM_WIDTH = MIX_WIDTH - SSD_WIDTH
SSD_HEAD_DIM = 64
SSD_HEADS = SSD_WIDTH // SSD_HEAD_DIM
SSD_GROUPS = 4
SSD_STATE = 128
SSD_CHUNK = 128
CONV_K = 3
BC_WIDTH = SSD_GROUPS * SSD_STATE
CONV_DIM = SSD_WIDTH + 2 * BC_WIDTH
CM_HEADS = 8
CM_HEAD_DIM = CM_WIDTH // CM_HEADS
CM_CHUNK = 128
IN_COLS = SSD_WIDTH + CONV_DIM + 2 * SSD_HEADS + 2 * CM_WIDTH
N_EXPERT_GROUPS = 4
EXPERTS_PER_GROUP = 8
EXPERT_TOP_K = 2
EXPERT_FF = D_MODEL // 4
N_MOD = 6
NORM_EPS = 1e-6
DT_MIN = 1e-3
DT_MAX = 1e-1

kernel_name = 'hybrid_bissd_chunkgmlp_hmoe_block'


def rmsnorm(x, g):
    xf = x.astype(jnp.float32)
    y = xf * lax.rsqrt(jnp.mean(xf * xf, axis=-1, keepdims=True) + NORM_EPS)
    return (y * g).astype(x.dtype)


def layernorm(x, g, b):
    xf = x.astype(jnp.float32)
    mu = jnp.mean(xf, axis=-1, keepdims=True)
    xc = xf - mu
    y = xc * lax.rsqrt(jnp.mean(xc * xc, axis=-1, keepdims=True) + NORM_EPS)
    return (y * g + b).astype(x.dtype)


def modulate(h, shift, scale):
    return h * (1.0 + scale) + shift


def dwconv_centred(x, w, b):
    k = w.shape[0]
    pad = k // 2
    n = x.shape[-2]
    xp = jnp.pad(x, [(0, 0)] * (x.ndim - 2) + [(pad, pad), (0, 0)])
    out = b
    for j in range(k):
        out = out + xp[..., j:j + n, :] * w[j]
    return out


def split_in_proj(p):
    s0 = SSD_WIDTH
    s1 = s0 + CONV_DIM
    s2 = s1 + SSD_HEADS
    s3 = s2 + SSD_HEADS
    s4 = s3 + CM_WIDTH
    return jnp.split(p, [s0, s1, s2, s3, s4], axis=-1)


def ssd_prepare(xbc, dt_f, dt_b, conv_w, conv_b, dt_bias_f, dt_bias_b, rows):
    bsz, n, _ = xbc.shape
    if rows is None:
        xbc = dwconv_centred(xbc, conv_w, conv_b)
    else:
        xbc = dwconv_centred(xbc.reshape(bsz, rows, GRID_W, CONV_DIM), conv_w, conv_b).reshape(bsz, n, CONV_DIM)
    xbc = jax.nn.silu(xbc)
    xs, bm, cm = jnp.split(xbc, [SSD_WIDTH, SSD_WIDTH + BC_WIDTH], axis=-1)
    xs = xs.reshape(bsz, n, SSD_HEADS, SSD_HEAD_DIM)
    bm = bm.reshape(bsz, n, SSD_GROUPS, SSD_STATE)
    cm = cm.reshape(bsz, n, SSD_GROUPS, SSD_STATE)
    dtf = jax.nn.softplus(dt_f.astype(jnp.float32) + dt_bias_f.astype(jnp.float32))
    dtb = jax.nn.softplus(dt_b.astype(jnp.float32) + dt_bias_b.astype(jnp.float32))
    return xs, bm, cm, dtf, dtb


def ssd_scan(xs, dt, a, bm, cm, h0, with_output):
    bsz, n, nh, hp = xs.shape
    g, ns = bm.shape[-2:]
    r = nh // g
    nc = n // SSD_CHUNK
    q = SSD_CHUNK
    dt = dt.reshape(bsz, nc, q, g, r)
    x_dt = xs.reshape(bsz, nc, q, g, r, hp) * dt[..., None]
    bc = bm.reshape(bsz, nc, q, g, ns)
    cc = cm.reshape(bsz, nc, q, g, ns)
    a_cum = jnp.cumsum(dt * a.reshape(g, r), axis=2)
    a_tot = a_cum[:, :, -1]
    decay_end = jnp.exp(a_tot[:, :, None] - a_cum)
    states = jnp.einsum('bcqgn,bcqgrp->bcgrpn', bc, x_dt * decay_end[..., None])

    def step(h, inp):
        s_c, a_c = inp
        return h * jnp.exp(a_c)[..., None, None] + s_c, h

    h_last, h_prev = lax.scan(step, h0.reshape(bsz, g, r, hp, ns).astype(jnp.float32),
                              (jnp.moveaxis(states, 1, 0), jnp.moveaxis(a_tot, 1, 0)))
    h_final = h_last.reshape(bsz, nh, hp, ns)
    if not with_output:
        return None, h_final
    h_prev = jnp.moveaxis(h_prev, 0, 1)
    y_off = jnp.einsum('bcqgn,bcgrpn->bcqgrp', cc, h_prev) * jnp.exp(a_cum)[..., None]
    seg = a_cum[:, :, :, None] - a_cum[:, :, None, :]
    lower = np.tri(q, dtype=bool)[:, :, None, None]
    decay = jnp.exp(jnp.where(lower, seg, -jnp.inf))
    cb = jnp.einsum('bcign,bcjgn->bcijg', cc, bc)
    y_diag = jnp.einsum('bcijgr,bcjgrp->bcigrp', cb[..., None] * decay, x_dt)
    y = (y_diag + y_off).reshape(bsz, n, nh, hp)
    return y, h_final


def bi_ssd(xs, dtf, dtb, a_f, a_b, bm, cm, h0_f, h0_b, with_output):
    y_f, h_f = ssd_scan(xs, dtf, a_f, bm, cm, h0_f, with_output)
    rev = lambda t: jnp.flip(t, axis=1)
    y_b, h_b = ssd_scan(rev(xs), rev(dtb), a_b, rev(bm), rev(cm), h0_b, with_output)
    y = y_f + rev(y_b) if with_output else None
    return y, h_f, h_b


def ssd_finish(y, xs, z, d_skip, norm_g):
    bsz, n = z.shape[:2]
    y = (y + xs * d_skip[:, None]).reshape(bsz, n, SSD_WIDTH).astype(z.dtype)
    return rmsnorm(y * jax.nn.silu(z), norm_g)


def chunk_gmlp(u, v, ln_g, ln_b, w_s, b_s):
    bsz, n, _ = u.shape
    nc = n // CM_CHUNK
    u = jax.nn.gelu(u)
    v = layernorm(jax.nn.gelu(v), ln_g, ln_b).reshape(bsz, nc, CM_CHUNK, CM_HEADS, CM_HEAD_DIM)
    s = jnp.einsum('gij,bcjgd->bcigd', w_s, v) + b_s.T[:, :, None]
    return u * s.reshape(bsz, n, CM_WIDTH)


def hier_moe(t, w_rg, b_rg, w_re, b_re, w_gate, w_up, w_down):
    p_g = jax.nn.softmax((t @ w_rg).astype(jnp.float32) + b_rg, axis=-1)
    top_pg, top_g = lax.top_k(p_g, 1)
    onehot_g = jax.nn.one_hot(top_g[:, 0], N_EXPERT_GROUPS, dtype=jnp.float32)
    logits_e = jnp.einsum('td,gde->tge', t, w_re).astype(jnp.float32) + b_re
    logits_sel = jnp.einsum('tge,tg->te', logits_e, onehot_g)
    top_le, top_e = lax.top_k(logits_sel, EXPERT_TOP_K)
    p_e = jax.nn.softmax(top_le, axis=-1) * top_pg
    w_e = jnp.einsum('tk,tke->te', p_e, jax.nn.one_hot(top_e, EXPERTS_PER_GROUP, dtype=jnp.float32))
    comb = (onehot_g[:, :, None] * w_e[:, None, :]).astype(t.dtype)
    out = jnp.zeros_like(t)
    for g in range(N_EXPERT_GROUPS):
        hid = jax.nn.silu(jnp.einsum('td,edf->tef', t, w_gate[g])) * jnp.einsum('td,edf->tef', t, w_up[g])
        out = out + jnp.einsum('tef,efd->td', hid * comb[:, g, :, None], w_down[g])
    return out


def setup_inputs(seed: int = 0) -> dict:
    key = jax.random.key(seed)
    ks = jax.random.split(key, 32)
    f32 = jnp.float32

    def nrm(k, shape, scale):
        return jax.random.normal(k, shape, f32) * scale

    L = DEPTH
    G, E, F = N_EXPERT_GROUPS, EXPERTS_PER_GROUP, EXPERT_FF
    log_lo, log_hi = math.log(DT_MIN), math.log(DT_MAX)
    dt0 = jnp.exp(jax.random.uniform(ks[8], (L, 2, SSD_HEADS), f32) * (log_hi - log_lo) + log_lo)
    dt_bias = dt0 + jnp.log(-jnp.expm1(-dt0))
    a_log = jnp.log(jax.random.uniform(ks[9], (L, 2, SSD_HEADS), f32, 1.0, 16.0))
    return {
        'x': nrm(ks[0], (BATCH, SEQ, D_MODEL), 1.0),
        'c': nrm(ks[1], (BATCH, D_MODEL), 1.0),
        'ctx': nrm(ks[2], (BATCH, CTX_LEN, D_MODEL), 1.0),
        'c_ctx': nrm(ks[3], (D_MODEL,), 1.0),
        'w_mod': nrm(ks[4], (L, D_MODEL, N_MOD * D_MODEL), 0.5 * D_MODEL ** -0.5),
        'b_mod': nrm(ks[5], (L, N_MOD * D_MODEL), 0.02),
        'norm1_g': 1.0 + nrm(ks[6], (L, D_MODEL), 0.02),
        'w_in': nrm(ks[7], (L, D_MODEL, IN_COLS), D_MODEL ** -0.5),
        'conv_w': nrm(ks[10], (L, CONV_K, CONV_DIM), CONV_K ** -0.5),
        'conv_b': nrm(ks[11], (L, CONV_DIM), 0.02),
        'dt_bias_f': dt_bias[:, 0],
        'dt_bias_b': dt_bias[:, 1],
        'a_log_f': a_log[:, 0],
        'a_log_b': a_log[:, 1],
        'd_skip': 1.0 + nrm(ks[12], (L, SSD_HEADS), 0.1),
        'ssd_norm_g': 1.0 + nrm(ks[13], (L, SSD_WIDTH), 0.02),
        'cm_ln_g': 1.0 + nrm(ks[14], (L, CM_WIDTH), 0.02),
        'cm_ln_b': nrm(ks[15], (L, CM_WIDTH), 0.02),
        'w_spatial': nrm(ks[16], (L, CM_HEADS, CM_CHUNK, CM_CHUNK), CM_CHUNK ** -0.5),
        'b_spatial': 1.0 + nrm(ks[17], (L, CM_HEADS, CM_CHUNK), 0.02),
        'w_out': nrm(ks[18], (L, MIX_WIDTH, D_MODEL), MIX_WIDTH ** -0.5),
        'norm2_g': 1.0 + nrm(ks[19], (L, D_MODEL), 0.02),
        'w_router_group': nrm(ks[20], (L, D_MODEL, G), D_MODEL ** -0.5),
        'b_router_group': nrm(ks[21], (L, G), 0.01),
        'w_router_expert': nrm(ks[22], (L, G, D_MODEL, E), D_MODEL ** -0.5),
        'b_router_expert': nrm(ks[23], (L, G, E), 0.01),
        'w_exp_gate': nrm(ks[24], (L, G, E, D_MODEL, F), D_MODEL ** -0.5),
        'w_exp_up': nrm(ks[25], (L, G, E, D_MODEL, F), D_MODEL ** -0.5),
        'w_exp_down': nrm(ks[26], (L, G, E, F, D_MODEL), F ** -0.5),
        'normf_g': 1.0 + nrm(ks[27], (D_MODEL,), 0.02),
    }


def reference(x, c, ctx, c_ctx, w_mod, b_mod, norm1_g, w_in, conv_w, conv_b, dt_bias_f, dt_bias_b,
              a_log_f, a_log_b, d_skip, ssd_norm_g, cm_ln_g, cm_ln_b, w_spatial, b_spatial, w_out,
              norm2_g, w_router_group, b_router_group, w_router_expert, b_router_expert,
              w_exp_gate, w_exp_up, w_exp_down, normf_g):
    bsz, seq_len, _ = x.shape
    rows = seq_len // GRID_W
    h_zero = jnp.zeros((bsz, SSD_HEADS, SSD_HEAD_DIM, SSD_STATE), jnp.float32)
    for i in range(DEPTH):
        last = i == DEPTH - 1
        mod_x = (jax.nn.silu(c) @ w_mod[i] + b_mod[i])[:, None, :]
        mod_c = jax.nn.silu(c_ctx) @ w_mod[i] + b_mod[i]
        sh1, sc1, g1, sh2, sc2, g2 = jnp.split(mod_x, N_MOD, axis=-1)
        csh1, csc1, cg1, csh2, csc2, cg2 = jnp.split(mod_c, N_MOD, axis=-1)
        a_f = -jnp.exp(a_log_f[i].astype(jnp.float32))
        a_b = -jnp.exp(a_log_b[i].astype(jnp.float32))
        p_x = modulate(rmsnorm(x, norm1_g[i]), sh1, sc1) @ w_in[i]
        p_c = modulate(rmsnorm(ctx, norm1_g[i]), csh1, csc1) @ w_in[i]
        z_x, xbc_x, dtf_x, dtb_x, u_x, v_x = split_in_proj(p_x)
        z_c, xbc_c, dtf_c, dtb_c, u_c, v_c = split_in_proj(p_c)
        xs_c, bm_c, cm_c, dtf_c, dtb_c = ssd_prepare(xbc_c, dtf_c, dtb_c, conv_w[i], conv_b[i],
                                                      dt_bias_f[i], dt_bias_b[i], None)
        y_c, hc_f, hc_b = bi_ssd(xs_c, dtf_c, dtb_c, a_f, a_b, bm_c, cm_c, h_zero, h_zero, not last)
        xs_x, bm_x, cm_x, dtf_x, dtb_x = ssd_prepare(xbc_x, dtf_x, dtb_x, conv_w[i], conv_b[i],
                                                      dt_bias_f[i], dt_bias_b[i], rows)
        y_x, _, _ = bi_ssd(xs_x, dtf_x, dtb_x, a_f, a_b, bm_x, cm_x, hc_f, hc_b, True)
        mix_x = jnp.concatenate([ssd_finish(y_x, xs_x, z_x, d_skip[i], ssd_norm_g[i]),
                                 chunk_gmlp(u_x, v_x, cm_ln_g[i], cm_ln_b[i], w_spatial[i], b_spatial[i])],
                                axis=-1)
        x = x + g1 * (mix_x @ w_out[i])
        moe_w = (w_router_group[i], b_router_group[i], w_router_expert[i], b_router_expert[i],
                 w_exp_gate[i], w_exp_up[i], w_exp_down[i])
        h2 = modulate(rmsnorm(x, norm2_g[i]), sh2, sc2)
        x = x + g2 * hier_moe(h2.reshape(-1, D_MODEL), *moe_w).reshape(x.shape)
        if not last:
            mix_c = jnp.concatenate([ssd_finish(y_c, xs_c, z_c, d_skip[i], ssd_norm_g[i]),
                                     chunk_gmlp(u_c, v_c, cm_ln_g[i], cm_ln_b[i], w_spatial[i], b_spatial[i])],
                                    axis=-1)
            ctx = ctx + cg1 * (mix_c @ w_out[i])
            h2c = modulate(rmsnorm(ctx, norm2_g[i]), csh2, csc2)
            ctx = ctx + cg2 * hier_moe(h2c.reshape(-1, D_MODEL), *moe_w).reshape(ctx.shape)
    return rmsnorm(x, normf_g)
```

```cpp
#include <hip/hip_runtime.h>
#include <cstdint>
#include <cstdio>

namespace nv {
constexpr int D = 2048, BATCH = 4, SEQ = 2048, T = BATCH * SEQ, CTXL = 256, TC = BATCH * CTXL;
constexpr int SSDW = 2048, CMW = 2048, HD = 64, NH = 32, NG = 4, NS = 128, CONVD = 3072;
constexpr int INC = 9280, NMOD = 6, FF = 512, NEXP = 32;
constexpr int C_Z = 0, C_X = 2048, C_B = 4096, C_C = 4608, C_DTF = 5120, C_DTB = 5152, C_U = 5184, C_V = 7232;
constexpr float EPS = 1e-6f;

__device__ __forceinline__ float silu_f(float x) { return x / (1.f + __expf(-x)); }
__device__ __forceinline__ float gelu_f(float x) { const float u = 0.7978845608028654f * (x + 0.044715f * x * x * x); return 0.5f * x * (1.f + tanhf(u)); }
__device__ __forceinline__ float softplus_f(float x) { return x > 20.f ? x : log1pf(__expf(x)); }

__device__ __forceinline__ float block_sum_256(float v, float* red) {
    for (int o = 32; o > 0; o >>= 1) v += __shfl_xor(v, o);
    __syncthreads();
    if ((threadIdx.x & 63) == 0) red[threadIdx.x >> 6] = v;
    __syncthreads();
    float s = red[0] + red[1] + red[2] + red[3];
    return s;
}

__global__ void __launch_bounds__(256) k_mod(const float* c, const float* cctx, const float* wmod, const float* bmod, float* mod) {
    __shared__ float s[5][D];
    for (int i = threadIdx.x; i < 5 * D; i += 256) { const int r = i / D, k = i % D; const float v = r < 4 ? c[r * D + k] : cctx[k]; s[r][k] = silu_f(v); }
    __syncthreads();
    const int j = blockIdx.x * 256 + threadIdx.x;
    float a0 = 0, a1 = 0, a2 = 0, a3 = 0, a4 = 0;
    for (int k = 0; k < D; ++k) { const float w = wmod[(size_t)k * (NMOD * D) + j]; a0 += s[0][k] * w; a1 += s[1][k] * w; a2 += s[2][k] * w; a3 += s[3][k] * w; a4 += s[4][k] * w; }
    const float b = bmod[j];
    mod[0 * NMOD * D + j] = a0 + b; mod[1 * NMOD * D + j] = a1 + b; mod[2 * NMOD * D + j] = a2 + b; mod[3 * NMOD * D + j] = a3 + b; mod[4 * NMOD * D + j] = a4 + b;
}

__global__ void __launch_bounds__(256) k_norm_mod(const float* in, const float* g, const float* mod, int rows_per_mod, int fixed_modrow, int shift_off, int scale_off, float* out) {
    __shared__ float red[8];
    const int row = blockIdx.x; const float* x = in + (size_t)row * D;
    float v[8]; float ss = 0.f;
#pragma unroll
    for (int i = 0; i < 8; ++i) { v[i] = x[threadIdx.x + 256 * i]; ss += v[i] * v[i]; }
    ss = block_sum_256(ss, red);
    const float r = rsqrtf(ss * (1.f / D) + EPS);
    const int mr = fixed_modrow >= 0 ? fixed_modrow : row / rows_per_mod;
    const float* m = mod + (size_t)mr * NMOD * D;
#pragma unroll
    for (int i = 0; i < 8; ++i) { const int k = threadIdx.x + 256 * i; out[(size_t)row * D + k] = v[i] * r * g[k] * (1.f + m[scale_off + k]) + m[shift_off + k]; }
}

__global__ void __launch_bounds__(256) k_gemm(const float* A, int lda, int ksplit, int koff2, const float* B, int ldb, float* C, int ldc, int K) {
    __shared__ float As[16][65];
    __shared__ float Bs[16][64];
    const int tx = threadIdx.x & 15, ty = threadIdx.x >> 4;
    const int m0 = blockIdx.y * 64, n0 = blockIdx.x * 64;
    float acc[4][4];
#pragma unroll
    for (int i = 0; i < 4; ++i)
#pragma unroll
        for (int j = 0; j < 4; ++j) acc[i][j] = 0.f;
    for (int k0 = 0; k0 < K; k0 += 16) {
#pragma unroll
        for (int i = 0; i < 4; ++i) { const int e = threadIdx.x + 256 * i; const int mm = e >> 4, kk = e & 15; const int k = k0 + kk; const int col = k < ksplit ? k : koff2 + (k - ksplit);
            As[kk][mm] = A[(size_t)(m0 + mm) * lda + col]; }
#pragma unroll
        for (int i = 0; i < 4; ++i) { const int e = threadIdx.x + 256 * i; const int kk = e >> 6, nn = e & 63; Bs[kk][nn] = B[(size_t)(k0 + kk) * ldb + n0 + nn]; }
        __syncthreads();
#pragma unroll
        for (int kk = 0; kk < 16; ++kk) {
            float a[4], b[4];
#pragma unroll
            for (int i = 0; i < 4; ++i) { a[i] = As[kk][ty * 4 + i]; b[i] = Bs[kk][tx * 4 + i]; }
#pragma unroll
            for (int i = 0; i < 4; ++i)
#pragma unroll
                for (int j = 0; j < 4; ++j) acc[i][j] += a[i] * b[j];
        }
        __syncthreads();
    }
#pragma unroll
    for (int i = 0; i < 4; ++i)
#pragma unroll
        for (int j = 0; j < 4; ++j) C[(size_t)(m0 + ty * 4 + i) * ldc + n0 + tx * 4 + j] = acc[i][j];
}

__global__ void __launch_bounds__(256) k_conv(float* P, int seglen, const float* cw, const float* cb) {
    const int seg = blockIdx.x, ch = blockIdx.y * 256 + threadIdx.x;
    float* base = P + (size_t)seg * seglen * INC + C_X + ch;
    const float w0 = cw[ch], w1 = cw[CONVD + ch], w2 = cw[2 * CONVD + ch], b = cb[ch];
    float prev = 0.f, cur = base[0];
    for (int s = 0; s < seglen; ++s) {
        const float nxt = (s + 1 < seglen) ? base[(size_t)(s + 1) * INC] : 0.f;
        const float o = b + w0 * prev + w1 * cur + w2 * nxt;
        base[(size_t)s * INC] = silu_f(o);
        prev = cur; cur = nxt;
    }
}
__global__ void __launch_bounds__(64) k_dt(float* P, const float* bf, const float* bb) {
    const int row = blockIdx.x, j = threadIdx.x;
    float* p = P + (size_t)row * INC + C_DTF + j;
    const float bias = j < 32 ? bf[j] : bb[j - 32];
    *p = softplus_f(*p + bias);
}

__global__ void __launch_bounds__(256) k_ssd(const float* P, const float* Pc, const float* alf, const float* alb, float* Y) {
    const int b = blockIdx.x / NH, h = blockIdx.x % NH, g = h / 8;
    const int p = threadIdx.x >> 2, nq = threadIdx.x & 3;
    for (int dir = 0; dir < 2; ++dir) {
        const float a = -__expf(dir == 0 ? alf[h] : alb[h]);
        float st[32];
#pragma unroll
        for (int n = 0; n < 32; ++n) st[n] = 0.f;
        for (int ph = 0; ph < 2; ++ph) {
            const int L = ph == 0 ? CTXL : SEQ;
            const float* base = (ph == 0 ? Pc : P) + (size_t)b * L * INC;
            for (int i = 0; i < L; ++i) {
                const int s = dir == 0 ? i : L - 1 - i;
                const float* row = base + (size_t)s * INC;
                const float dt = row[(dir == 0 ? C_DTF : C_DTB) + h];
                const float xv = row[C_X + h * HD + p];
                const float dec = __expf(a * dt), coef = dt * xv;
                const float4* Bp = (const float4*)(row + C_B + g * NS + nq * 32);
                const float4* Cp = (const float4*)(row + C_C + g * NS + nq * 32);
                float y = 0.f;
#pragma unroll
                for (int q = 0; q < 8; ++q) {
                    const float4 bv = Bp[q], cv = Cp[q];
                    st[4 * q + 0] = st[4 * q + 0] * dec + coef * bv.x; y += cv.x * st[4 * q + 0];
                    st[4 * q + 1] = st[4 * q + 1] * dec + coef * bv.y; y += cv.y * st[4 * q + 1];
                    st[4 * q + 2] = st[4 * q + 2] * dec + coef * bv.z; y += cv.z * st[4 * q + 2];
                    st[4 * q + 3] = st[4 * q + 3] * dec + coef * bv.w; y += cv.w * st[4 * q + 3];
                }
                if (ph == 1) {
                    y += __shfl_xor(y, 1); y += __shfl_xor(y, 2);
                    if (nq == 0) { float* yp = Y + (size_t)(b * SEQ + s) * SSDW + h * HD + p; if (dir == 0) *yp = y; else *yp += y; }
                }
            }
        }
    }
}

__global__ void __launch_bounds__(256) k_ssd_finish(float* P, const float* Y, const float* dskip, const float* ng) {
    __shared__ float red[8];
    const int row = blockIdx.x; float* pr = P + (size_t)row * INC;
    float v[8]; float ss = 0.f;
#pragma unroll
    for (int i = 0; i < 8; ++i) { const int k = threadIdx.x + 256 * i; const float y = Y[(size_t)row * SSDW + k] + pr[C_X + k] * dskip[k / HD]; v[i] = y * silu_f(pr[C_Z + k]); ss += v[i] * v[i]; }
    ss = block_sum_256(ss, red);
    const float r = rsqrtf(ss * (1.f / SSDW) + EPS);
#pragma unroll
    for (int i = 0; i < 8; ++i) { const int k = threadIdx.x + 256 * i; pr[C_Z + k] = v[i] * r * ng[k]; }
}

__global__ void __launch_bounds__(256) k_gmlp_ln(float* P, const float* lg, const float* lb) {
    __shared__ float red[8];
    const int row = blockIdx.x; float* pr = P + (size_t)row * INC + C_V;
    float v[8]; float s = 0.f;
#pragma unroll
    for (int i = 0; i < 8; ++i) { v[i] = gelu_f(pr[threadIdx.x + 256 * i]); s += v[i]; }
    s = block_sum_256(s, red);
    const float mu = s * (1.f / CMW); float q = 0.f;
#pragma unroll
    for (int i = 0; i < 8; ++i) { v[i] -= mu; q += v[i] * v[i]; }
    q = block_sum_256(q, red);
    const float r = rsqrtf(q * (1.f / CMW) + EPS);
#pragma unroll
    for (int i = 0; i < 8; ++i) { const int k = threadIdx.x + 256 * i; pr[k] = v[i] * r * lg[k] + lb[k]; }
}
__global__ void __launch_bounds__(256) k_gmlp_sp(float* P, const float* ws, const float* bs) {
    const int bc = blockIdx.x, g = blockIdx.y, ch = g * 256 + threadIdx.x;
    float* base = P + (size_t)bc * 128 * INC;
    for (int i = 0; i < 128; ++i) {
        const float* w = ws + ((size_t)g * 128 + i) * 128;
        float acc = 0.f;
        for (int j = 0; j < 128; ++j) acc += w[j] * base[(size_t)j * INC + C_V + ch];
        float* up = base + (size_t)i * INC + C_U + ch;
        *up = gelu_f(*up) * (acc + bs[g * 128 + i]);
    }
}

__global__ void __launch_bounds__(256) k_resid(const float* x, const float* O, const float* mod, int goff, float* x1) {
    const size_t i = (size_t)blockIdx.x * 256 + threadIdx.x; const int row = (int)(i / D), k = (int)(i % D), b = row / SEQ;
    x1[i] = x[i] + mod[(size_t)b * NMOD * D + goff + k] * O[i];
}

__global__ void __launch_bounds__(64) k_router(const float* h2, const float* wrg, const float* brg, const float* wre, const float* bre, int* rte, float* rtw) {
    __shared__ float lg[36];
    const int t = blockIdx.x; const float* hr = h2 + (size_t)t * D;
    if (threadIdx.x < 36) {
        const int j = threadIdx.x; float acc = 0.f;
        if (j < 4) { for (int k = 0; k < D; ++k) acc += hr[k] * wrg[k * 4 + j]; acc += brg[j]; }
        else { const int g = (j - 4) / 8, e = (j - 4) % 8; for (int k = 0; k < D; ++k) acc += hr[k] * wre[((size_t)g * D + k) * 8 + e]; acc += bre[g * 8 + e]; }
        lg[j] = acc;
    }
    __syncthreads();
    if (threadIdx.x == 0) {
        int bg = 0; float bm = lg[0];
        for (int j = 1; j < 4; ++j) if (lg[j] > bm) { bm = lg[j]; bg = j; }
        float den = 0.f; for (int j = 0; j < 4; ++j) den += __expf(lg[j] - bm);
        const float pg = 1.f / den;
        const float* le = lg + 4 + bg * 8;
        int i1 = 0; for (int j = 1; j < 8; ++j) if (le[j] > le[i1]) i1 = j;
        int i2 = -1; for (int j = 0; j < 8; ++j) if (j != i1 && (i2 < 0 || le[j] > le[i2])) i2 = j;
        const float e2 = __expf(le[i2] - le[i1]); const float p1 = 1.f / (1.f + e2), p2 = e2 / (1.f + e2);
        rte[2 * t] = bg * 8 + i1; rte[2 * t + 1] = bg * 8 + i2; rtw[2 * t] = p1 * pg; rtw[2 * t + 1] = p2 * pg;
    }
}

__global__ void __launch_bounds__(256) k_moe_final(const float* h2, const float* x1, const int* rte, const float* rtw, const float* wg, const float* wu, const float* wd,
                                                   const float* mod, int goff, const float* nfg, float* out) {
    __shared__ float hs[D]; __shared__ float hid[FF]; __shared__ float red[8];
    const int t = blockIdx.x, b = t / SEQ, tid = threadIdx.x;
    for (int i = tid; i < D; i += 256) hs[i] = h2[(size_t)t * D + i];
    float acc[8];
#pragma unroll
    for (int i = 0; i < 8; ++i) acc[i] = 0.f;
    for (int kk = 0; kk < 2; ++kk) {
        const int e = rte[2 * t + kk]; const float w = rtw[2 * t + kk];
        const float* G = wg + (size_t)e * D * FF; const float* U = wu + (size_t)e * D * FF; const float* Dn = wd + (size_t)e * FF * D;
        __syncthreads();
        float g0 = 0, g1 = 0, u0 = 0, u1 = 0;
        for (int k = 0; k < D; ++k) { const float hv = hs[k]; g0 += hv * G[(size_t)k * FF + tid]; g1 += hv * G[(size_t)k * FF + tid + 256]; u0 += hv * U[(size_t)k * FF + tid]; u1 += hv * U[(size_t)k * FF + tid + 256]; }
        hid[tid] = silu_f(g0) * u0 * w; hid[tid + 256] = silu_f(g1) * u1 * w;
        __syncthreads();
        for (int f = 0; f < FF; ++f) { const float hv = hid[f];
#pragma unroll
            for (int i = 0; i < 8; ++i) acc[i] += hv * Dn[(size_t)f * D + tid + 256 * i]; }
    }
    float v[8]; float ss = 0.f;
#pragma unroll
    for (int i = 0; i < 8; ++i) { const int k = tid + 256 * i; v[i] = x1[(size_t)t * D + k] + mod[(size_t)b * NMOD * D + goff + k] * acc[i]; ss += v[i] * v[i]; }
    ss = block_sum_256(ss, red);
    const float r = rsqrtf(ss * (1.f / D) + EPS);
#pragma unroll
    for (int i = 0; i < 8; ++i) { const int k = tid + 256 * i; out[(size_t)t * D + k] = v[i] * r * nfg[k]; }
}
}

extern "C" void kernel_launch(void* const* d_in, const int* in_sizes, int n_in, void* d_out, int out_size, void* d_ws, size_t ws_size, hipStream_t stream) {
    using namespace nv;
    const float* x = (const float*)d_in[0]; const float* c = (const float*)d_in[1]; const float* ctx = (const float*)d_in[2]; const float* cctx = (const float*)d_in[3];
    const float* wmod = (const float*)d_in[4]; const float* bmod = (const float*)d_in[5]; const float* n1g = (const float*)d_in[6]; const float* win = (const float*)d_in[7];
    const float* convw = (const float*)d_in[8]; const float* convb = (const float*)d_in[9]; const float* dtbf = (const float*)d_in[10]; const float* dtbb = (const float*)d_in[11];
    const float* alf = (const float*)d_in[12]; const float* alb = (const float*)d_in[13]; const float* dskip = (const float*)d_in[14]; const float* sng = (const float*)d_in[15];
    const float* lng = (const float*)d_in[16]; const float* lnb = (const float*)d_in[17]; const float* wsp = (const float*)d_in[18]; const float* bsp = (const float*)d_in[19];
    const float* wout = (const float*)d_in[20]; const float* n2g = (const float*)d_in[21]; const float* wrg = (const float*)d_in[22]; const float* brg = (const float*)d_in[23];
    const float* wre = (const float*)d_in[24]; const float* bre = (const float*)d_in[25]; const float* weg = (const float*)d_in[26]; const float* weu = (const float*)d_in[27];
    const float* wed = (const float*)d_in[28]; const float* nfg = (const float*)d_in[29];
    float* out = (float*)d_out;
    char* ws = (char*)d_ws; size_t off = 0;
    auto take = [&](size_t bytes) { char* p = ws + off; off += (bytes + 255) & ~(size_t)255; return p; };
    float* mod = (float*)take((size_t)5 * NMOD * D * 4);
    float* xn = (float*)take((size_t)T * D * 4);
    float* P = (float*)take((size_t)T * INC * 4);
    float* Pc = (float*)take((size_t)TC * INC * 4);
    float* Y = (float*)take((size_t)T * SSDW * 4);
    float* h2 = (float*)take((size_t)T * D * 4);
    int* rte = (int*)take((size_t)T * 2 * 4); float* rtw = (float*)take((size_t)T * 2 * 4);
    if (off > ws_size) { fprintf(stderr, "workspace too small: need %zu have %zu\n", off, ws_size); return; }
    float* ctxn = h2;

    k_mod<<<NMOD * D / 256, 256, 0, stream>>>(c, cctx, wmod, bmod, mod);
    k_norm_mod<<<T, 256, 0, stream>>>(x, n1g, mod, SEQ, -1, 0, D, xn);
    k_norm_mod<<<TC, 256, 0, stream>>>(ctx, n1g, mod, 1, 4, 0, D, ctxn);
    k_gemm<<<dim3(INC / 64, T / 64), 256, 0, stream>>>(xn, D, D, 0, win, INC, P, INC, D);
    k_gemm<<<dim3(INC / 64, TC / 64), 256, 0, stream>>>(ctxn, D, D, 0, win, INC, Pc, INC, D);
    k_conv<<<dim3(T / 64, CONVD / 256), 256, 0, stream>>>(P, 64, convw, convb);
    k_conv<<<dim3(TC / CTXL, CONVD / 256), 256, 0, stream>>>(Pc, CTXL, convw, convb);
    k_dt<<<T, 64, 0, stream>>>(P, dtbf, dtbb);
    k_dt<<<TC, 64, 0, stream>>>(Pc, dtbf, dtbb);
    k_ssd<<<BATCH * NH, 256, 0, stream>>>(P, Pc, alf, alb, Y);
    k_ssd_finish<<<T, 256, 0, stream>>>(P, Y, dskip, sng);
    k_gmlp_ln<<<T, 256, 0, stream>>>(P, lng, lnb);
    k_gmlp_sp<<<dim3(T / 128, 8), 256, 0, stream>>>(P, wsp, bsp);
    float* O = Y;
    k_gemm<<<dim3(D / 64, T / 64), 256, 0, stream>>>(P, INC, SSDW, C_U, wout, D, O, D, 2 * D);
    float* x1 = xn;
    k_resid<<<T * D / 256, 256, 0, stream>>>(x, O, mod, 2 * D, x1);
    k_norm_mod<<<T, 256, 0, stream>>>(x1, n2g, mod, SEQ, -1, 3 * D, 4 * D, h2);
    k_router<<<T, 64, 0, stream>>>(h2, wrg, brg, wre, bre, rte, rtw);
    k_moe_final<<<T, 256, 0, stream>>>(h2, x1, rte, rtw, weg, weu, wed, mod, 5 * D, nfg, out);
}
```

```cpp
#include <hip/hip_runtime.h>
#include <cstdint>
#include <cstdio>

#define GAS __attribute__((address_space(1)))
#define LAS __attribute__((address_space(3)))
typedef unsigned short bf16_t;
typedef short bf16x8 __attribute__((ext_vector_type(8)));
typedef float f32x4 __attribute__((ext_vector_type(4)));
typedef float f32x2 __attribute__((ext_vector_type(2)));
typedef unsigned u32x4 __attribute__((ext_vector_type(4)));
typedef unsigned u32x2 __attribute__((ext_vector_type(2)));
typedef GAS unsigned gu32;

constexpr int D = 2048, BATCH = 4, SEQ = 2048, T = BATCH * SEQ, CTXL = 256, TC = BATCH * CTXL, TR = T + TC;
constexpr int NH = 32, HD = 64, NG = 4, NS = 128, CH = 128, NCH = SEQ / CH, NCHC = CTXL / CH;
constexpr int NCHUNK_L = BATCH * NCH, NCHUNK_ALL = NCHUNK_L + BATCH * NCHC;
constexpr int INC = 9280, NMOD = 6, FF = 512, NEXP = 32;
constexpr int WIN_ROWS = 9472;
constexpr int PW = 9216;
constexpr int PC_Z = 0, PC_X = 2048, PC_B = 4096, PC_C = 4608, PC_U = 5120, PC_V = 7168;
constexpr float EPS = 1e-6f;
constexpr int NWAVES = 8, NTHR = 512;

constexpr size_t MiB = 1u << 20;
constexpr size_t WS_CTL = 0, CTL_BYTES = 1 * MiB;
constexpr size_t CTL_MOD = 64 * 1024;
constexpr size_t CTL_LNST = 320 * 1024;
constexpr size_t CTL_SSQ1 = 384 * 1024;
constexpr size_t CTL_CNT = 416 * 1024;
constexpr size_t WS_WIN = 1 * MiB, WS_WOUT = 38 * MiB, WS_WGU = 54 * MiB, WS_WD = 182 * MiB, WS_WRT = 246 * MiB;
constexpr size_t WS_XN = 247 * MiB;
constexpr size_t WS_P = 283 * MiB;
constexpr size_t WS_X1 = WS_P, WS_H2 = WS_P + 64 * MiB, WS_YMOE = WS_P + 96 * MiB;
constexpr size_t WS_DT = 445 * MiB;
constexpr size_t WS_YF = 448 * MiB, WS_YB = 480 * MiB, WS_MIX = 512 * MiB;
constexpr size_t WS_CC = 576 * MiB, WS_BC = 584 * MiB, WS_BCT = 592 * MiB, WS_VT = 601 * MiB;
constexpr size_t WS_LIST = 633 * MiB, WS_WTS = 634 * MiB, WS_END = 636 * MiB;
constexpr int CW_TMO = 0, CW_CODE = 1, CW_BAR = 4096;

constexpr int RING_BYTES = 131072, LDSCTL_OFF = RING_BYTES, MISC_OFF = LDSCTL_OFF + 320, SMALL_OFF = LDSCTL_OFF + 1024;
constexpr int LDS_BYTES = 147456;

#define RLX_AGENT __ATOMIC_RELAXED, __HIP_MEMORY_SCOPE_AGENT
#define LDS_WAIT() asm volatile("s_waitcnt lgkmcnt(0)" ::: "memory")
#define VM_WAIT() asm volatile("s_waitcnt vmcnt(0)" ::: "memory")

__device__ __forceinline__ unsigned f2bf(float f) { unsigned u = __builtin_bit_cast(unsigned, f); return (u + 0x7fffu + ((u >> 16) & 1u)) >> 16; }
__device__ __forceinline__ unsigned pk2(float lo, float hi) { return f2bf(lo) | (f2bf(hi) << 16); }
__device__ __forceinline__ float bf2f(unsigned short h) { return __builtin_bit_cast(float, (unsigned)h << 16); }
__device__ __forceinline__ float bflo(unsigned w) { return __builtin_bit_cast(float, w << 16); }
__device__ __forceinline__ float bfhi(unsigned w) { return __builtin_bit_cast(float, w & 0xffff0000u); }
__device__ __forceinline__ float silu_f(float x) { return x * __builtin_amdgcn_rcpf(1.f + __expf(-x)); }
__device__ __forceinline__ float gelu_f(float x) { const float u = 1.5957691216057308f * (x + 0.044715f * x * x * x); return x * __builtin_amdgcn_rcpf(1.f + __expf(-u)); }
__device__ __forceinline__ float softplus_f(float x) { return x > 20.f ? x : log1pf(__expf(x)); }
__device__ __forceinline__ float wave_sum(float v) {
#pragma unroll
    for (int o = 1; o < 64; o <<= 1) v += __shfl_xor(v, o);
    return v;
}

#define XB_TMO      128
#define XB_XCNT(j)  (256  + 64 * (j))
#define XB_XSUB(j)  (1280 + 64 * (j))
#define XB_XGEN(j)  (2304 + 64 * (j))
#define XB_TOP      3328
#define XB_TOPGEN   3392
#define XCD_BAR_WORDS 3456
#define XB_SPIN_CAP (1u << 18)
__device__ __forceinline__ unsigned xb_ld(unsigned* p)              { return __hip_atomic_load(p, __ATOMIC_RELAXED, __HIP_MEMORY_SCOPE_AGENT); }
__device__ __forceinline__ unsigned xb_add(unsigned* p, unsigned v) { return __hip_atomic_fetch_add(p, v, __ATOMIC_RELAXED, __HIP_MEMORY_SCOPE_AGENT); }
__device__ __forceinline__ unsigned xb_xcc_id() { return (unsigned)__builtin_amdgcn_s_getreg((3 << 11) | 20) & 0xFu; }
#define XB_SPIN(cond, bar) do { unsigned _sp = 0; while (cond) { __builtin_amdgcn_s_sleep(1); \
    if ((++_sp & 255u) == 0u) { if (xb_ld(&(bar)[XB_TMO])) break; if (_sp > XB_SPIN_CAP) { atomicAdd(&(bar)[XB_TMO], 1u); break; } } } } while (0)
struct XcdBarrier { unsigned* bar; unsigned x; volatile LAS unsigned* st; };
__device__ __forceinline__ XcdBarrier xcd_barrier_post(unsigned* bar, volatile LAS unsigned* st) {
    XcdBarrier b; b.bar = bar; b.x = xb_xcc_id(); b.st = st;
    if (threadIdx.x == 0) (void)xb_add(&bar[XB_XCNT(b.x)], 1u);
    return b;
}
__device__ __forceinline__ void xcd_barrier_complete(unsigned* bar, unsigned x, unsigned& nloc, unsigned& nx) {
    const unsigned G = gridDim.x * gridDim.y * gridDim.z;
    unsigned sum, cnt, mine, sp = 0u;
    for (;;) {
        sum = 0u; cnt = 0u; mine = 0u;
#pragma unroll
        for (unsigned j = 0; j < 16; ++j) { const unsigned c = xb_ld(&bar[XB_XCNT(j)]); sum += c; cnt += (c > 0u) ? 1u : 0u; mine = (j == x) ? c : mine; }
        if (sum == G) break;
        __builtin_amdgcn_s_sleep(1);
        if ((++sp & 255u) == 0u) { if (xb_ld(&bar[XB_TMO])) break; if (sp > XB_SPIN_CAP) { atomicAdd(&bar[XB_TMO], 1u); break; } }
    }
    nloc = mine > 0u ? mine : 1u; nx = cnt > 0u ? cnt : 1u;
}
__device__ __forceinline__ void xcd_barrier(const XcdBarrier& b) {
    asm volatile("s_waitcnt vmcnt(0)" ::: "memory");
    __syncthreads();
    if (threadIdx.x == 0) {
        unsigned* bar = b.bar;
        __builtin_amdgcn_s_waitcnt(0);
        unsigned nloc = b.st[0], nx = b.st[1];
        if (nloc == 0u) { xcd_barrier_complete(bar, b.x, nloc, nx); b.st[0] = nloc; b.st[1] = nx; }
        const unsigned old = xb_add(&bar[XB_XSUB(b.x)], 1u);
        const unsigned gen = old / nloc;
        if (old + 1u == (gen + 1u) * nloc) {
            __builtin_amdgcn_fence(__ATOMIC_RELEASE, "agent");
            asm volatile("s_waitcnt vmcnt(0)" ::: "memory");
            const unsigned og = xb_add(&bar[XB_TOP], 1u);
            const unsigned tg = og / nx;
            if (og + 1u == (tg + 1u) * nx) xb_add(&bar[XB_TOPGEN], 1u);
            else XB_SPIN(xb_ld(&bar[XB_TOPGEN]) == tg, bar);
            __builtin_amdgcn_fence(__ATOMIC_ACQUIRE, "agent");
            xb_add(&bar[XB_XGEN(b.x)], 1u);
            asm volatile("s_waitcnt vmcnt(0)" ::: "memory");
        } else {
            XB_SPIN(xb_ld(&bar[XB_XGEN(b.x)]) == gen, bar);
            __builtin_amdgcn_fence(__ATOMIC_ACQUIRE, "agent");
            asm volatile("s_waitcnt vmcnt(0)" ::: "memory");
        }
    }
    __syncthreads();
}
namespace pg8 {
#define PG8_LAS __attribute__((address_space(3)))
constexpr int BM = 256, BK = 64, HALF = 128, HTB = HALF * BK * 2, STAGE_BYTES = 8 * HTB, NXCD = 8, WGM = 8;
__host__ __device__ __forceinline__ int lds_byte(int r, int c) { const int st = (r >> 4) * 2 + (c >> 5), rr = r & 15, cc = c & 31, ob = rr * 64 + cc * 2; return st * 1024 + (ob ^ (((ob >> 9) & 1) << 5)); }
__host__ __device__ __forceinline__ void stage_rc(int b, int& R, int& C) { const int st = b / 1024, sb = b % 1024, swz = sb ^ (((sb >> 9) & 1) << 5); R = (st >> 1) * 16 + swz / 64; C = (st & 1) * 32 + (swz % 64) / 2; }
__host__ __device__ __forceinline__ int perm32(int rho) { const int n = rho >> 4, i = rho & 15; return 8 * (i >> 2) + 4 * n + (i & 3); }

struct Unit { int pm, pn, e, mt; };
struct Gemm { const bf16_t* A; const bf16_t* Bt; int K; };

__device__ __forceinline__ unsigned cvt_pk_bf16(float lo, float hi) { unsigned r; asm volatile("v_cvt_pk_bf16_f32 %0, %1, %2" : "=v"(r) : "v"(lo), "v"(hi)); return r; }

template <class Epi, class Sched, bool GATHER = false>
__device__ __forceinline__ void gemm_phase(PG8_LAS unsigned char* lds, const Gemm g, const Sched& S, const Epi& E) {
    const int tid = threadIdx.x, wid = __builtin_amdgcn_readfirstlane(tid >> 6), lane = tid & 63, wr = wid >> 2, wc = wid & 3, fr = lane & 15, fq = lane >> 4;
    const int K = g.K, nt = K / BK;
    unsigned voffA[2], voffB[2];
#pragma unroll
    for (int i = 0; i < 2; ++i) { int R, C; stage_rc(tid * 16 + i * 8192, R, C); const int Rb = Epi::PERM ? ((R & ~31) + perm32(R & 31)) : R;
        voffA[i] = (unsigned)(R * K + C) * 2u; voffB[i] = (unsigned)(Rb * K + C) * 2u; }
    const size_t kstep = (size_t)(BK * 2);
    const size_t hstep = (size_t)HALF * K * 2;
    const size_t tstep = 2 * hstep;
    const unsigned ldsw = (unsigned)wid * 1024u;
    const int aoff = lds_byte(wr * 64 + fr, fq * 8), boff = lds_byte(wc * 32 + fr, fq * 8);
#define PG8_SA(b, h) (((b) * 2 + (h)) * HTB)
#define PG8_SB(b, h) ((4 + (b) * 2 + (h)) * HTB)
#define PG8_STAGE(bufoff, gbase, voff) do { _Pragma("unroll") for (int _i = 0; _i < 2; ++_i) \
        __builtin_amdgcn_global_load_lds((const unsigned*)((const char*)(gbase) + (voff)[_i]), (PG8_LAS unsigned*)(lds + (bufoff) + ldsw + _i * 8192), 16, 0, 0); } while (0)
#define PG8_STAGE_A(bufoff, gbase, h, usenext) do { if constexpr (GATHER) { PG8_STAGE(bufoff, gbase, cvo[h]); } \
        else PG8_STAGE(bufoff, (gbase) + (h) * hstep, voffA); } while (0)
#define PG8_GOFF(u, h, i, dst) do { int _t = tid; asm volatile("" : "+v"(_t)); int _R, _C; stage_rc(_t * 16 + (i) * 8192, _R, _C); dst = (unsigned)(S.arow(u, (h) * HALF + _R) * K + _C) * 2u; } while (0)
#define PG8_LDA(dst, b, h) do { _Pragma("unroll") for (int m = 0; m < 4; ++m) _Pragma("unroll") for (int k = 0; k < 2; ++k) dst[m][k] = *(const PG8_LAS bf16x8*)(lds + PG8_SA(b, h) + aoff + m * 2048 + k * 1024); } while (0)
#define PG8_LDB(dst, b, h) do { _Pragma("unroll") for (int n = 0; n < 2; ++n) _Pragma("unroll") for (int k = 0; k < 2; ++k) dst[n][k] = *(const PG8_LAS bf16x8*)(lds + PG8_SB(b, h) + boff + n * 2048 + k * 1024); } while (0)
#define PG8_MMA(ai, bj, At, Bt) do { __builtin_amdgcn_s_setprio(1); _Pragma("unroll") for (int m = 0; m < 4; ++m) _Pragma("unroll") for (int n = 0; n < 2; ++n) _Pragma("unroll") for (int k = 0; k < 2; ++k) \
        acc[ai][bj][m][n] = __builtin_amdgcn_mfma_f32_16x16x32_bf16(Bt[n][k], At[m][k], acc[ai][bj][m][n], 0, 0, 0); __builtin_amdgcn_s_setprio(0); } while (0)
#define PG8_WAIT_V(n) asm volatile("s_waitcnt vmcnt(" #n ")" ::: "memory")
#define PG8_WAIT_L(n) asm volatile("s_waitcnt lgkmcnt(" #n ")" ::: "memory")
#define PG8_BAR __builtin_amdgcn_s_barrier()
#define PG8_SCHED __builtin_amdgcn_sched_barrier(0)
    Unit cur, nxt; int ui = 0;
    if (!S.next(0, cur)) return;
    f32x4 acc[2][2][4][2];
#pragma unroll
    for (int a = 0; a < 2; ++a)
#pragma unroll
        for (int b = 0; b < 2; ++b)
#pragma unroll
            for (int m = 0; m < 4; ++m)
#pragma unroll
                for (int n = 0; n < 2; ++n) acc[a][b][m][n] = (f32x4){0.f, 0.f, 0.f, 0.f};
    bf16x8 At[4][2], B0[2][2], B1[2][2];
    unsigned cvo[2][2];
#pragma unroll
    for (int h = 0; h < 2; ++h)
#pragma unroll
        for (int i = 0; i < 2; ++i) cvo[h][i] = 0u;
    if constexpr (GATHER) {
#pragma unroll
        for (int h = 0; h < 2; ++h)
#pragma unroll
            for (int i = 0; i < 2; ++i) PG8_GOFF(cur, h, i, cvo[h][i]);
    }
    const char* cA = GATHER ? (const char*)g.A : (const char*)g.A + (size_t)cur.pm * tstep; const char* cB = (const char*)g.Bt + (size_t)cur.pn * tstep;
    PG8_STAGE(PG8_SB(0, 0), cB, voffB); PG8_STAGE(PG8_SB(0, 1), cB + hstep, voffB); PG8_STAGE_A(PG8_SA(0, 0), cA, 0, false); PG8_STAGE_A(PG8_SA(0, 1), cA, 1, false);
    if (wr == 1) PG8_BAR;
    PG8_WAIT_V(2); PG8_BAR;
    PG8_STAGE(PG8_SB(1, 0), cB + kstep, voffB); PG8_STAGE_A(PG8_SA(1, 0), cA + kstep, 0, false); PG8_STAGE(PG8_SB(1, 1), cB + hstep + kstep, voffB);
    PG8_WAIT_V(6); PG8_BAR;
    for (;;) {
        const bool has_next = S.next(ui + 1, nxt);
        const char* nA = GATHER ? cA : (has_next ? (const char*)g.A + (size_t)nxt.pm * tstep : cA); const char* nB = has_next ? (const char*)g.Bt + (size_t)nxt.pn * tstep : cB;
        for (int t = 0; t < nt; t += 2) {
            const bool last = (t == nt - 2);
            const char* a1 = cA + (size_t)(t + 1) * kstep;
            const char* a2 = last ? nA : cA + (size_t)(t + 2) * kstep; const char* b2 = last ? nB : cB + (size_t)(t + 2) * kstep;
            const char* a3 = a2 + kstep; const char* b3 = b2 + kstep;
            PG8_LDB(B0, 0, 0); PG8_LDB(B1, 0, 1); PG8_SCHED; PG8_LDA(At, 0, 0); PG8_STAGE_A(PG8_SA(1, 1), a1, 1, false);
            if constexpr (GATHER) { if (last && has_next) {
#pragma unroll
                for (int h = 0; h < 2; ++h)
#pragma unroll
                    for (int i = 0; i < 2; ++i) PG8_GOFF(nxt, h, i, cvo[h][i]); } }
            PG8_WAIT_V(8); PG8_WAIT_L(0); PG8_BAR; PG8_MMA(0, 0, At, B0); PG8_MMA(0, 1, At, B1); PG8_BAR; PG8_SCHED;
            PG8_LDA(At, 0, 1); PG8_STAGE(PG8_SB(0, 0), b2, voffB); PG8_STAGE(PG8_SB(0, 1), b2 + hstep, voffB); PG8_STAGE_A(PG8_SA(0, 0), a2, 0, last);
            PG8_WAIT_V(8); PG8_WAIT_L(0); PG8_BAR; PG8_MMA(1, 0, At, B0); PG8_MMA(1, 1, At, B1); PG8_BAR; PG8_SCHED;
            PG8_LDB(B0, 1, 0); PG8_LDB(B1, 1, 1); PG8_SCHED; PG8_LDA(At, 1, 0); PG8_STAGE_A(PG8_SA(0, 1), a2, 1, last);
            PG8_WAIT_V(8); PG8_WAIT_L(0); PG8_BAR; PG8_MMA(0, 0, At, B0); PG8_MMA(0, 1, At, B1); PG8_BAR; PG8_SCHED;
            PG8_LDA(At, 1, 1); PG8_STAGE(PG8_SB(1, 0), b3, voffB); PG8_STAGE(PG8_SB(1, 1), b3 + hstep, voffB); PG8_STAGE_A(PG8_SA(1, 0), a3, 0, last);
            PG8_WAIT_V(8); PG8_WAIT_L(0); PG8_BAR; PG8_MMA(1, 0, At, B0); PG8_MMA(1, 1, At, B1); PG8_BAR; PG8_SCHED;
        }
        if (wr == 0) PG8_BAR;
        E(acc, cur, wr, wc, fr, fq);
        if (!has_next) break;
#pragma unroll
        for (int a = 0; a < 2; ++a)
#pragma unroll
            for (int b = 0; b < 2; ++b)
#pragma unroll
                for (int m = 0; m < 4; ++m)
#pragma unroll
                    for (int n = 0; n < 2; ++n) acc[a][b][m][n] = (f32x4){0.f, 0.f, 0.f, 0.f};
        cur = nxt; cA = nA; cB = nB; ++ui;
        if (wr == 1) PG8_BAR;
    }
    PG8_WAIT_V(0);
    PG8_BAR;
#undef PG8_SA
#undef PG8_SB
#undef PG8_STAGE
#undef PG8_STAGE_A
#undef PG8_GOFF
#undef PG8_LDA
#undef PG8_LDB
#undef PG8_MMA
#undef PG8_WAIT_V
#undef PG8_WAIT_L
#undef PG8_BAR
#undef PG8_SCHED
}
}
struct Args { const float* in[30]; float* out; unsigned char* ws; int ph_lo, ph_hi, li, pad; };
struct Frame {
    LAS unsigned char* lds;
    int tid, lane, wave, G, bid;
};

__device__ __forceinline__ void transpose_item(const float* W, int K, int N, bf16_t* WT, int drow0, LAS float* scr, int kb, int nb, int lane) {
    const int k0 = 64 * kb, n0 = 32 * nb;
#pragma unroll 8
    for (int i = 0; i < 32; ++i) { const int kk = 2 * i + (lane >> 5); scr[kk * 33 + (lane & 31)] = W[(size_t)(k0 + kk) * N + n0 + (lane & 31)]; }
    LDS_WAIT(); asm volatile("" ::: "memory");
    const int c = lane & 7;
#pragma unroll
    for (int j = 0; j < 4; ++j) { const int n = (lane >> 3) + 8 * j; const LAS float* s = scr + (8 * c) * 33 + n;
        u32x4 o; o.x = pk2(s[0 * 33], s[1 * 33]); o.y = pk2(s[2 * 33], s[3 * 33]); o.z = pk2(s[4 * 33], s[5 * 33]); o.w = pk2(s[6 * 33], s[7 * 33]);
        *(GAS u32x4*)(WT + (size_t)(drow0 + n) * K + k0 + 8 * c) = o; }
    LDS_WAIT(); asm volatile("" ::: "memory");
}

__device__ __forceinline__ void p0_phase(Frame& F, const Args& a) {
    unsigned char* ws = a.ws;
    const float* c = a.in[1]; const float* cctx = a.in[3]; const float* wmod = a.in[4]; const float* bmod = a.in[5];
    float* mod = (float*)(ws + WS_CTL + CTL_MOD);
    LAS float* sT = (LAS float*)(F.lds + 73728);
    LAS float* red = (LAS float*)(F.lds);
    for (int i = F.tid; i < 5 * D; i += NTHR) { const int r = i / D, k = i % D; const float v = r < 4 ? c[r * D + k] : cctx[k]; sT[i] = silu_f(v); }
    __syncthreads();
    for (int it = F.bid; it < 768; it += F.G) {
        const int cb = it % 48, kc = it / 48;
        const int kbase = kc * 128 + F.wave * 16;
        const float* wp = wmod + (size_t)kbase * (NMOD * D) + cb * 256 + F.lane * 4;
        f32x4 wv[16];
#pragma unroll
        for (int r = 0; r < 16; ++r) wv[r] = *(const GAS f32x4*)(wp + (size_t)r * (NMOD * D));
        f32x4 acc[5];
#pragma unroll
        for (int b = 0; b < 5; ++b) acc[b] = (f32x4){0.f, 0.f, 0.f, 0.f};
#pragma unroll
        for (int r = 0; r < 16; ++r) {
#pragma unroll
            for (int b = 0; b < 5; ++b) { const float s = sT[b * D + kbase + r]; acc[b] += s * wv[r]; }
        }
#pragma unroll
        for (int b = 0; b < 5; ++b)
#pragma unroll
            for (int j = 0; j < 4; ++j) red[(F.wave * 20 + b * 4 + j) * 64 + F.lane] = acc[b][j];
        __syncthreads();
        for (int o = F.tid; o < 1280; o += NTHR) {
            const int b = o >> 8, col = o & 255, ln = col >> 2, j = col & 3; float s = 0.f;
#pragma unroll
            for (int w = 0; w < 8; ++w) s += red[(w * 20 + b * 4 + j) * 64 + ln];
            if (kc == 0) s += bmod[cb * 256 + col];
            atomicAdd(mod + b * (NMOD * D) + cb * 256 + col, s);
        }
        __syncthreads();
    }
    LAS float* scr = (LAS float*)(F.lds + F.wave * 8448);
    const int gw = F.bid * NWAVES + F.wave, NGW = F.G * NWAVES;
    constexpr int I_IN = 32 * 290, I_OUT = 64 * 64, I_E = 32 * 512, NITEMS = I_IN + I_OUT + 3 * I_E;
    bf16_t* WinT = (bf16_t*)(ws + WS_WIN); bf16_t* WoutT = (bf16_t*)(ws + WS_WOUT); bf16_t* WguT = (bf16_t*)(ws + WS_WGU); bf16_t* WdT = (bf16_t*)(ws + WS_WD);
    for (int it = gw; it < NITEMS; it += NGW) {
        int r = it;
        if (r < I_IN) { const int kb = r / 290, nb = r % 290; const int n0 = nb * 32; const int drow = n0 + (n0 >= 5184 ? 192 : 0);
            transpose_item(a.in[7], D, INC, WinT, drow, scr, kb, nb, F.lane); continue; }
        r -= I_IN;
        if (r < I_OUT) { const int kb = r / 64, nb = r % 64; transpose_item(a.in[20], 2 * D, D, WoutT, nb * 32, scr, kb, nb, F.lane); continue; }
        r -= I_OUT;
        if (r < 2 * I_E) { const int up = r >= I_E; if (up) r -= I_E; const int e = r / 512, q = r % 512, kb = q / 16, nb = q % 16; const int f0 = nb * 32;
            const int drow = e * 1024 + (f0 >> 7) * 256 + (f0 & 127) + (up ? 128 : 0);
            transpose_item((up ? a.in[27] : a.in[26]) + (size_t)e * D * FF, D, FF, WguT, drow, scr, kb, nb, F.lane); continue; }
        r -= 2 * I_E;
        { const int e = r / 512, q = r % 512, kb = q / 64, nb = q % 64;
          transpose_item(a.in[28] + (size_t)e * FF * D, FF, D, WdT + (size_t)e * D * FF, nb * 32, scr, kb, nb, F.lane); }
    }
    const int gt = F.bid * NTHR + F.tid, NGT = F.G * NTHR;
    for (int i = gt; i < 192 * D / 8; i += NGT) *(GAS u32x4*)(WinT + (size_t)5184 * D + (size_t)i * 8) = (u32x4){0u, 0u, 0u, 0u};
    float* WrT = (float*)(ws + WS_WRT);
    for (int i = gt; i < 36 * D; i += NGT) { const int j = i / D, k = i % D;
        WrT[i] = j < 4 ? a.in[22][k * 4 + j] : a.in[24][((size_t)((j - 4) >> 3) * D + k) * 8 + ((j - 4) & 7)]; }
}

__device__ __forceinline__ void norm_rows_phase(Frame& F, const float* xl, const float* xc, const float* g, const float* mod, int shift_off, int scale_off, bf16_t* out) {
    const int gw = F.bid * NWAVES + F.wave, NGW = F.G * NWAVES;
    for (int row = gw; row < TR; row += NGW) {
        const float* xr = row < T ? xl + (size_t)row * D : xc + (size_t)(row - T) * D;
        const float* m = mod + (size_t)(row < T ? row / SEQ : 4) * (NMOD * D);
        f32x4 v[8]; float ss = 0.f;
#pragma unroll
        for (int j = 0; j < 8; ++j) { v[j] = *(const GAS f32x4*)(xr + 4 * F.lane + 256 * j); ss += (v[j].x * v[j].x + v[j].y * v[j].y) + (v[j].z * v[j].z + v[j].w * v[j].w); }
        const float r = rsqrtf(wave_sum(ss) * (1.f / D) + EPS);
#pragma unroll
        for (int j = 0; j < 8; ++j) { const int k = 4 * F.lane + 256 * j;
            const f32x4 gv = *(const GAS f32x4*)(g + k), sc = *(const GAS f32x4*)(m + scale_off + k), sh = *(const GAS f32x4*)(m + shift_off + k);
            const f32x4 o = v[j] * r * gv * (sc + 1.0f) + sh;
            u32x2 w; w.x = pk2(o.x, o.y); w.y = pk2(o.z, o.w);
            *(GAS u32x2*)(out + (size_t)row * D + k) = w; }
    }
}

struct InOrder {
    int G, c;
    __device__ __forceinline__ bool next(int i, pg8::Unit& u) const {
        const int L = i * G + c; if (L >= 1184 + 52) return false;
        u.e = 0; u.mt = 0;
        if (L < 1184) { constexpr int nM = 32, nN = 37, nwg = nM * nN; int wgid = L; { const int q = nwg / 8, xcd = wgid % 8, off = wgid / 8; wgid = xcd * q + off; }
            const int nig = 8 * nN, gid = wgid / nig, fm = gid * 8; u.pm = fm + ((wgid % nig) % 8); u.pn = (wgid % nig) / 8; return true; }
        const int r = L - 1184; u.pm = 32 + r % 4; u.pn = 8 + r / 4; return true;
    }
};
struct EpiIn {
    static constexpr bool PERM = true;
    bf16_t* P; float* dtraw; float* lnstat;
    __device__ __forceinline__ void operator()(const f32x4 (&acc)[2][2][4][2], const pg8::Unit& u, int wr, int wc, int fr, int fq) const {
        const int pn = u.pn; const int row0 = u.pm * 256 + wr * 64 + fr;
        if (pn == 20) {
            if (wc < 2) {
#pragma unroll
                for (int ai = 0; ai < 2; ++ai)
#pragma unroll
                    for (int m = 0; m < 4; ++m) { float* rp = dtraw + (size_t)(row0 + ai * 128 + m * 16) * 64 + wc * 32 + 8 * fq;
                        *(GAS f32x4*)(rp) = acc[ai][0][m][0]; *(GAS f32x4*)(rp + 4) = acc[ai][0][m][1]; }
            }
            return;
        }
        const int mode = pn < 8 ? 1 : (pn < 20 ? 0 : 2);
        const bool stats = pn >= 29;
        const int pcol = (pn < 20 ? pn : pn - 1) * 256 + wc * 32 + 8 * fq;
#pragma unroll
        for (int ai = 0; ai < 2; ++ai)
#pragma unroll
            for (int m = 0; m < 4; ++m) {
                const int row = row0 + ai * 128 + m * 16; bf16_t* rowp = P + (size_t)row * PW + pcol; float s = 0.f, q = 0.f;
#pragma unroll
                for (int bj = 0; bj < 2; ++bj) { f32x4 v0 = acc[ai][bj][m][0], v1 = acc[ai][bj][m][1];
                    if (mode == 1) {
#pragma unroll
                        for (int j = 0; j < 4; ++j) { v0[j] = silu_f(v0[j]); v1[j] = silu_f(v1[j]); } }
                    else if (mode == 2) {
#pragma unroll
                        for (int j = 0; j < 4; ++j) { v0[j] = gelu_f(v0[j]); v1[j] = gelu_f(v1[j]); }
                        if (stats) {
#pragma unroll
                            for (int j = 0; j < 4; ++j) { s += v0[j] + v1[j]; q += v0[j] * v0[j] + v1[j] * v1[j]; } } }
                    u32x4 w; w.x = pg8::cvt_pk_bf16(v0[0], v0[1]); w.y = pg8::cvt_pk_bf16(v0[2], v0[3]); w.z = pg8::cvt_pk_bf16(v1[0], v1[1]); w.w = pg8::cvt_pk_bf16(v1[2], v1[3]);
                    *(GAS u32x4*)(rowp + bj * 128) = w; }
                if (stats) { s += __shfl_xor(s, 16); s += __shfl_xor(s, 32); q += __shfl_xor(q, 16); q += __shfl_xor(q, 32);
                    if (fq == 0) { atomicAdd(lnstat + 2 * (size_t)row, s); atomicAdd(lnstat + 2 * (size_t)row + 1, q); } }
            }
    }
};
__device__ __forceinline__ void finish_phase(Frame& F, const bf16_t* P, const bf16_t* Yf, const bf16_t* Yb, const float* ng, bf16_t* mixA) {
    const int gw = F.bid * NWAVES + F.wave, NGW = F.G * NWAVES;
    for (int row = gw; row < T; row += NGW) {
        float v[4][8]; float ss = 0.f;
#pragma unroll
        for (int j = 0; j < 4; ++j) { const int col = (F.lane + 64 * j) * 8;
            const u32x4 a = *(const GAS u32x4*)(Yf + (size_t)row * 2048 + col), b = *(const GAS u32x4*)(Yb + (size_t)row * 2048 + col), z = *(const GAS u32x4*)(P + (size_t)row * PW + PC_Z + col);
#pragma unroll
            for (int q = 0; q < 4; ++q) { v[j][2 * q] = (bflo(a[q]) + bflo(b[q])) * bflo(z[q]); v[j][2 * q + 1] = (bfhi(a[q]) + bfhi(b[q])) * bfhi(z[q]); ss += v[j][2 * q] * v[j][2 * q] + v[j][2 * q + 1] * v[j][2 * q + 1]; } }
        const float r = rsqrtf(wave_sum(ss) * (1.f / 2048) + EPS);
#pragma unroll
        for (int j = 0; j < 4; ++j) { const int col = (F.lane + 64 * j) * 8; const f32x4 g0 = *(const GAS f32x4*)(ng + col), g1 = *(const GAS f32x4*)(ng + col + 4);
            u32x4 w; w.x = pk2(v[j][0] * r * g0.x, v[j][1] * r * g0.y); w.y = pk2(v[j][2] * r * g0.z, v[j][3] * r * g0.w); w.z = pk2(v[j][4] * r * g1.x, v[j][5] * r * g1.y); w.w = pk2(v[j][6] * r * g1.z, v[j][7] * r * g1.w);
            *(GAS u32x4*)(mixA + (size_t)row * 4096 + col) = w; }
    }
}
struct OutOrder {
    int G, c;
    __device__ __forceinline__ bool next(int i, pg8::Unit& u) const {
        const int L = i * G + c; if (L >= 256) return false;
        constexpr int nN = 8, nwg = 256; int wgid = L; { const int q = nwg / 8, xcd = wgid % 8, off = wgid / 8; wgid = xcd * q + off; }
        const int nig = 8 * nN, gid = wgid / nig, fm = gid * 8; u.pm = fm + ((wgid % nig) % 8); u.pn = (wgid % nig) / 8; u.e = 0; u.mt = 0; return true;
    }
};
struct EpiOut {
    static constexpr bool PERM = false;
    const float* x; const float* mod; float* x1; float* ssq1;
    __device__ __forceinline__ void operator()(const f32x4 (&acc)[2][2][4][2], const pg8::Unit& u, int wr, int wc, int fr, int fq) const {
        const int row0 = u.pm * 256 + wr * 64 + fr, col0 = u.pn * 256 + wc * 32 + 4 * fq;
        const float* g1 = mod + (size_t)(u.pm / 8) * (NMOD * D) + 2 * D;
        f32x4 gv[2][2];
#pragma unroll
        for (int bj = 0; bj < 2; ++bj)
#pragma unroll
            for (int n = 0; n < 2; ++n) gv[bj][n] = *(const GAS f32x4*)(g1 + col0 + bj * 128 + n * 16);
#pragma unroll
        for (int ai = 0; ai < 2; ++ai)
#pragma unroll
            for (int m = 0; m < 4; ++m) { const int row = row0 + ai * 128 + m * 16; const size_t off = (size_t)row * D + col0; float q = 0.f;
#pragma unroll
                for (int bj = 0; bj < 2; ++bj)
#pragma unroll
                    for (int n = 0; n < 2; ++n) { const f32x4 xv = *(const GAS f32x4*)(x + off + bj * 128 + n * 16); const f32x4 o = xv + gv[bj][n] * acc[ai][bj][m][n];
                        *(GAS f32x4*)(x1 + off + bj * 128 + n * 16) = o; q += (o.x * o.x + o.y * o.y) + (o.z * o.z + o.w * o.w); }
                q += __shfl_xor(q, 16); q += __shfl_xor(q, 32);
                if (fq == 0) atomicAdd(ssq1 + row, q); }
    }
};
__device__ __forceinline__ void route_phase(Frame& F, const float* x1, const float* ssq1, const float* n2g, const float* mod, const float* WrT, const float* brg, const float* bre,
                                            bf16_t* h2, int* cnt, int* list, float* wts) {
    LAS float* lgs = (LAS float*)(F.lds) + F.wave * 160;
    const int gw = F.bid * NWAVES + F.wave, NGW = F.G * NWAVES;
    for (int q4 = gw; q4 < T / 4; q4 += NGW) {
        const int t0 = q4 * 4; const float* m = mod + (size_t)(t0 / SEQ) * (NMOD * D);
        f32x4 h[4][8];
        float r[4];
#pragma unroll
        for (int tk = 0; tk < 4; ++tk) { r[tk] = rsqrtf(ssq1[t0 + tk] * (1.f / D) + EPS);
#pragma unroll
            for (int j = 0; j < 8; ++j) h[tk][j] = *(const GAS f32x4*)(x1 + (size_t)(t0 + tk) * D + 4 * F.lane + 256 * j); }
#pragma unroll
        for (int j = 0; j < 8; ++j) { const int k = 4 * F.lane + 256 * j;
            const f32x4 gv = *(const GAS f32x4*)(n2g + k), sc = *(const GAS f32x4*)(m + 4 * D + k), sh = *(const GAS f32x4*)(m + 3 * D + k);
            const f32x4 gs = gv * (sc + 1.0f);
#pragma unroll
            for (int tk = 0; tk < 4; ++tk) { h[tk][j] = h[tk][j] * r[tk] * gs + sh; u32x2 w; w.x = pk2(h[tk][j].x, h[tk][j].y); w.y = pk2(h[tk][j].z, h[tk][j].w);
                *(GAS u32x2*)(h2 + (size_t)(t0 + tk) * D + k) = w; } }
        for (int jo = 0; jo < 36; ++jo) {
            const float* wp = WrT + (size_t)jo * D + 4 * F.lane;
            float a0 = 0.f, a1 = 0.f, a2 = 0.f, a3 = 0.f;
#pragma unroll
            for (int j = 0; j < 8; ++j) { const f32x4 w = *(const GAS f32x4*)(wp + 256 * j);
                a0 += (h[0][j].x * w.x + h[0][j].y * w.y) + (h[0][j].z * w.z + h[0][j].w * w.w);
                a1 += (h[1][j].x * w.x + h[1][j].y * w.y) + (h[1][j].z * w.z + h[1][j].w * w.w);
                a2 += (h[2][j].x * w.x + h[2][j].y * w.y) + (h[2][j].z * w.z + h[2][j].w * w.w);
                a3 += (h[3][j].x * w.x + h[3][j].y * w.y) + (h[3][j].z * w.z + h[3][j].w * w.w); }
            a0 = wave_sum(a0); a1 = wave_sum(a1); a2 = wave_sum(a2); a3 = wave_sum(a3);
            if (F.lane == 0) { const float bias = jo < 4 ? brg[jo] : bre[jo - 4]; lgs[0 * 40 + jo] = a0 + bias; lgs[1 * 40 + jo] = a1 + bias; lgs[2 * 40 + jo] = a2 + bias; lgs[3 * 40 + jo] = a3 + bias; }
        }
        LDS_WAIT(); asm volatile("" ::: "memory");
        if (F.lane < 4) {
            const LAS float* lg = lgs + F.lane * 40; const int t = t0 + F.lane;
            int bg = 0; float bm = lg[0];
            for (int j = 1; j < 4; ++j) { const float v = lg[j]; if (v > bm) { bm = v; bg = j; } }
            float den = 0.f; for (int j = 0; j < 4; ++j) den += __expf(lg[j] - bm);
            const float pg = 1.f / den;
            const LAS float* le = lg + 4 + bg * 8;
            int i1 = 0; float v1 = le[0];
            for (int j = 1; j < 8; ++j) { const float v = le[j]; if (v > v1) { v1 = v; i1 = j; } }
            int i2 = -1; float v2 = 0.f;
            for (int j = 0; j < 8; ++j) { const float v = le[j]; if (j != i1 && (i2 < 0 || v > v2)) { v2 = v; i2 = j; } }
            const float e2 = __expf(v2 - v1); const float p1 = 1.f / (1.f + e2), p2 = e2 / (1.f + e2);
            const int ea = bg * 8 + i1, eb = bg * 8 + i2;
            const int pa = atomicAdd(cnt + ea, 1), pb = atomicAdd(cnt + eb, 1);
            list[ea * T + pa] = 2 * t; list[eb * T + pb] = 2 * t + 1; wts[2 * t] = p1 * pg; wts[2 * t + 1] = p2 * pg;
        }
        LDS_WAIT(); asm volatile("" ::: "memory");
    }
}

__device__ __forceinline__ void moe_table(Frame& F, const int* cnt, LAS int* tab) {
    if (F.tid < 32) tab[40 + F.tid] = __hip_atomic_load(cnt + F.tid, RLX_AGENT);
    __syncthreads();
    if (F.tid == 0) { int s = 0; for (int e = 0; e < 32; ++e) { tab[e] = s; s += (tab[40 + e] + 255) >> 8; } tab[32] = s; }
    __syncthreads();
}
template <int NTN> struct MoeOrder {
    int G, c; const LAS int* tab; const int* list;
    __device__ __forceinline__ bool next(int i, pg8::Unit& u) const {
        const int L = i * G + c; const int total = tab[32] * NTN; if (L >= total) return false;
        const int mtg = L / NTN, nt = L % NTN; int e = 0;
        for (int k = 1; k < 32; ++k) if (tab[k] <= mtg) e = k;
        u.e = e; u.mt = mtg - tab[e]; u.pm = mtg; u.pn = e * NTN + nt; return true;
    }
    __device__ __forceinline__ int arow(const pg8::Unit& u, int r) const { const int pos = u.mt * 256 + r; return pos < tab[40 + u.e] ? (list[u.e * T + pos] >> 1) : 0; }
};
struct EpiGU {
    static constexpr bool PERM = true;
    bf16_t* Hid; const LAS int* tab; const int* list; const float* wts;
    __device__ __forceinline__ void operator()(const f32x4 (&acc)[2][2][4][2], const pg8::Unit& u, int wr, int wc, int fr, int fq) const {
        const int nt = u.pn & 3, cn = tab[40 + u.e];
#pragma unroll
        for (int ai = 0; ai < 2; ++ai)
#pragma unroll
            for (int m = 0; m < 4; ++m) { const int r = ai * 128 + wr * 64 + m * 16 + fr, pos = u.mt * 256 + r; float w = 0.f;
                if (pos < cn) w = wts[list[u.e * T + pos]];
                float o[8];
#pragma unroll
                for (int n = 0; n < 2; ++n)
#pragma unroll
                    for (int j = 0; j < 4; ++j) o[4 * n + j] = silu_f(acc[ai][0][m][n][j]) * acc[ai][1][m][n][j] * w;
                u32x4 pk; pk.x = pg8::cvt_pk_bf16(o[0], o[1]); pk.y = pg8::cvt_pk_bf16(o[2], o[3]); pk.z = pg8::cvt_pk_bf16(o[4], o[5]); pk.w = pg8::cvt_pk_bf16(o[6], o[7]);
                *(GAS u32x4*)(Hid + (size_t)(u.pm * 256 + r) * FF + nt * 128 + wc * 32 + 8 * fq) = pk; }
    }
};
struct EpiDown {
    static constexpr bool PERM = true;
    bf16_t* Y; const LAS int* tab; const int* list;
    __device__ __forceinline__ void operator()(const f32x4 (&acc)[2][2][4][2], const pg8::Unit& u, int wr, int wc, int fr, int fq) const {
        const int nt = u.pn & 7, cn = tab[40 + u.e];
#pragma unroll
        for (int ai = 0; ai < 2; ++ai)
#pragma unroll
            for (int m = 0; m < 4; ++m) { const int r = ai * 128 + wr * 64 + m * 16 + fr, pos = u.mt * 256 + r;
                if (pos < cn) { const int ts = list[u.e * T + pos]; bf16_t* rp = Y + (size_t)ts * D + nt * 256 + wc * 32 + 8 * fq;
#pragma unroll
                    for (int bj = 0; bj < 2; ++bj) { const f32x4 v0 = acc[ai][bj][m][0], v1 = acc[ai][bj][m][1];
                        u32x4 pk; pk.x = pg8::cvt_pk_bf16(v0[0], v0[1]); pk.y = pg8::cvt_pk_bf16(v0[2], v0[3]); pk.z = pg8::cvt_pk_bf16(v1[0], v1[1]); pk.w = pg8::cvt_pk_bf16(v1[2], v1[3]);
                        *(GAS u32x4*)(rp + bj * 128) = pk; } } }
    }
};
__device__ __forceinline__ void final_phase(Frame& F, const float* x1, const bf16_t* Y, const float* mod, const float* nfg, float* out) {
    const int gw = F.bid * NWAVES + F.wave, NGW = F.G * NWAVES;
    for (int t = gw; t < T; t += NGW) {
        const float* g2 = mod + (size_t)(t / SEQ) * (NMOD * D) + 5 * D;
        f32x4 v[8]; float ss = 0.f;
#pragma unroll
        for (int j = 0; j < 8; ++j) { const int k = 4 * F.lane + 256 * j;
            const f32x4 xv = *(const GAS f32x4*)(x1 + (size_t)t * D + k), gv = *(const GAS f32x4*)(g2 + k);
            const u32x2 y0 = *(const GAS u32x2*)(Y + (size_t)(2 * t) * D + k), y1 = *(const GAS u32x2*)(Y + (size_t)(2 * t + 1) * D + k);
            f32x4 ys; ys.x = bflo(y0.x) + bflo(y1.x); ys.y = bfhi(y0.x) + bfhi(y1.x); ys.z = bflo(y0.y) + bflo(y1.y); ys.w = bfhi(y0.y) + bfhi(y1.y);
            v[j] = xv + gv * ys; ss += (v[j].x * v[j].x + v[j].y * v[j].y) + (v[j].z * v[j].z + v[j].w * v[j].w); }
        const float r = rsqrtf(wave_sum(ss) * (1.f / D) + EPS);
#pragma unroll
        for (int j = 0; j < 8; ++j) { const int k = 4 * F.lane + 256 * j; const f32x4 gv = *(const GAS f32x4*)(nfg + k); *(GAS f32x4*)(out + (size_t)t * D + k) = v[j] * r * gv; }
    }
}
__device__ __forceinline__ void p2a_phase(Frame& F, const bf16_t* P, const float* cw, const float* cb, bf16_t* Cc, bf16_t* Bc, bf16_t* BcT, bf16_t* XT, bf16_t* VT) {
    constexpr int N_X = NCHUNK_ALL * 32, N_B = NCHUNK_ALL * 8, N_C = NCHUNK_L * 8, N_V = NCHUNK_L * 32, N_ALL = N_X + N_B + N_C + N_V;
    constexpr int RAWP = 72, OTP = 136;
    LAS bf16_t* raw = (LAS bf16_t*)(F.lds); LAS bf16_t* outT = (LAS bf16_t*)(F.lds + 20480);
    for (int it = F.bid; it < N_ALL; it += F.G) {
        int kind, ck, sub;
        if (it < N_X) { kind = 0; ck = it >> 5; sub = it & 31; }
        else if (it < N_X + N_B) { kind = 1; const int r = it - N_X; ck = r >> 3; sub = r & 7; }
        else if (it < N_X + N_B + N_C) { kind = 2; const int r = it - N_X - N_B; ck = r >> 3; sub = r & 7; }
        else { kind = 3; const int r = it - N_X - N_B - N_C; ck = r >> 5; sub = r & 31; }
        const bool lat = ck < NCHUNK_L;
        const int row0 = lat ? ck * CH : T + (ck - NCHUNK_L) * CH;
        const int cpos = lat ? (ck & 15) * CH : ((ck - NCHUNK_L) & 1) * CH;
        const int seg = lat ? 64 : CTXL;
        const int scol = kind == 0 ? PC_X + sub * 64 : kind == 1 ? PC_B + sub * 64 : kind == 2 ? PC_C + sub * 64 : PC_V + sub * 64;
        for (int q = F.tid; q < 130 * 8; q += NTHR) { const int lr = q >> 3, c8 = q & 7, tr = lr - 1;
            bool ok = true;
            if (tr < 0) ok = (cpos % seg) != 0; else if (tr >= CH) ok = ((cpos + CH) % seg) != 0;
            u32x4 v = (u32x4){0u, 0u, 0u, 0u};
            if (ok) v = *(const GAS u32x4*)(P + (size_t)(row0 + tr) * PW + scol + c8 * 8);
            *(LAS u32x4*)(raw + lr * RAWP + c8 * 8) = v; }
        __syncthreads();
        const int cg = F.tid & 7;
        float w0[8], w1[8], w2[8], bb[8];
        if (kind != 3) { const int cch = scol - PC_X + cg * 8;
#pragma unroll
            for (int c = 0; c < 8; ++c) { w0[c] = cw[cch + c]; w1[c] = cw[3072 + cch + c]; w2[c] = cw[2 * 3072 + cch + c]; bb[c] = cb[cch + c]; } }
        else {
#pragma unroll
            for (int c = 0; c < 8; ++c) { w0[c] = 0.f; w1[c] = 0.f; w2[c] = 0.f; bb[c] = 0.f; } }
#pragma unroll
        for (int k = 0; k < 2; ++k) {
            const int tr = (F.tid >> 3) + 64 * k; const int s = cpos + tr;
            const u32x4 cur = *(const LAS u32x4*)(raw + (tr + 1) * RAWP + cg * 8);
            u32x4 res;
            if (kind != 3) {
                const bool pv = (s % seg) != 0, nv = (s % seg) != seg - 1;
                u32x4 prv = *(const LAS u32x4*)(raw + (tr) * RAWP + cg * 8), nxt = *(const LAS u32x4*)(raw + (tr + 2) * RAWP + cg * 8);
                if (!pv) prv = (u32x4){0u, 0u, 0u, 0u};
                if (!nv) nxt = (u32x4){0u, 0u, 0u, 0u};
                float o[8];
#pragma unroll
                for (int q = 0; q < 4; ++q) {
                    o[2 * q] = silu_f(bb[2 * q] + w0[2 * q] * bflo(prv[q]) + w1[2 * q] * bflo(cur[q]) + w2[2 * q] * bflo(nxt[q]));
                    o[2 * q + 1] = silu_f(bb[2 * q + 1] + w0[2 * q + 1] * bfhi(prv[q]) + w1[2 * q + 1] * bfhi(cur[q]) + w2[2 * q + 1] * bfhi(nxt[q])); }
                res.x = pk2(o[0], o[1]); res.y = pk2(o[2], o[3]); res.z = pk2(o[4], o[5]); res.w = pk2(o[6], o[7]);
            } else res = cur;
            if (kind == 2 || (kind == 1 && lat)) { bf16_t* dst = (kind == 2 ? Cc : Bc) + (size_t)(row0 + tr) * 512 + sub * 64 + cg * 8; *(GAS u32x4*)dst = res; }
            if (kind != 2) {
#pragma unroll
                for (int q = 0; q < 4; ++q) { outT[(cg * 8 + 2 * q) * OTP + tr] = (bf16_t)(res[q] & 0xffffu); outT[(cg * 8 + 2 * q + 1) * OTP + tr] = (bf16_t)(res[q] >> 16); } }
        }
        __syncthreads();
        if (kind != 2) {
            bf16_t* dbase = kind == 0 ? XT + ((size_t)(ck * 32 + sub) * 64) * CH : kind == 1 ? BcT + ((size_t)(ck * 4 + (sub >> 1)) * 128 + (sub & 1) * 64) * CH : VT + ((size_t)ck * 2048 + sub * 64) * CH;
#pragma unroll
            for (int k = 0; k < 2; ++k) { const int q = F.tid + NTHR * k, rr = q >> 4, part = q & 15;
                *(GAS u32x4*)(dbase + (size_t)rr * CH + part * 8) = *(const LAS u32x4*)(outT + rr * OTP + part * 8); }
        }
        __syncthreads();
    }
}
__device__ __forceinline__ int img(int row, int chunk) { return row * 256 + ((chunk ^ (row & 15)) << 4); }
__device__ __forceinline__ bf16x8 frag(const LAS unsigned char* base, int r0, int s, int fr, int fq) { return *(const LAS bf16x8*)(base + img(r0 + fr, 4 * s + fq)); }
#define MFMA16(a, b, c) __builtin_amdgcn_mfma_f32_16x16x32_bf16(a, b, c, 0, 0, 0)
constexpr int I_C = 0, I_B = 32768, I_BT = 65536, I_XT = 98304, I_H = 114688;

struct SsdLoad { u32x4 c[4], b[4], bt[4], xt[2]; float dt[2]; };

__device__ __forceinline__ void ssd_issue(Frame& F, SsdLoad& L, bool full, int ck, int row0, int g, int h, int dir, const bf16_t* Cc, const bf16_t* Bc, const bf16_t* BcT, const bf16_t* XT, const float* dtraw, float bias) {
    if (full) {
#pragma unroll
        for (int k = 0; k < 4; ++k) { const int q = F.tid + NTHR * k, r = q >> 4, cch = q & 15;
            L.c[k] = *(const GAS u32x4*)(Cc + (size_t)(row0 + r) * 512 + g * 128 + cch * 8); L.b[k] = *(const GAS u32x4*)(Bc + (size_t)(row0 + r) * 512 + g * 128 + cch * 8); }
    }
#pragma unroll
    for (int k = 0; k < 4; ++k) { const int q = F.tid + NTHR * k; L.bt[k] = *(const GAS u32x4*)(BcT + (size_t)(ck * 4 + g) * 128 * CH + (size_t)q * 8); }
#pragma unroll
    for (int k = 0; k < 2; ++k) { const int q = F.tid + NTHR * k; L.xt[k] = *(const GAS u32x4*)(XT + (size_t)(ck * 32 + h) * 64 * CH + (size_t)q * 8); }
    L.dt[0] = softplus_f(dtraw[(size_t)(row0 + F.lane) * 64 + dir * 32 + h] + bias); L.dt[1] = softplus_f(dtraw[(size_t)(row0 + F.lane + 64) * 64 + dir * 32 + h] + bias);
}
__device__ __forceinline__ float ssd_tables(Frame& F, const SsdLoad& L, LAS float* sm, float a, int dir) {
    const float e0 = dir == 0 ? L.dt[0] : __shfl(L.dt[1], 63 - F.lane);
    const float e1 = dir == 0 ? L.dt[1] : __shfl(L.dt[0], 63 - F.lane);
    float s0 = e0, s1 = e1;
#pragma unroll
    for (int d = 1; d < 64; d <<= 1) { const float t0 = __shfl_up(s0, d), t1 = __shfl_up(s1, d); if (F.lane >= d) { s0 += t0; s1 += t1; } }
    const float tot0 = __shfl(s0, 63); s1 += tot0;
    const float tot = a * __shfl(s1, 63);
    if (F.wave == 0) {
        const int i0 = dir == 0 ? F.lane : 127 - F.lane, i1 = dir == 0 ? F.lane + 64 : 63 - F.lane;
        const float ac0 = a * s0, ac1 = a * s1;
        sm[i0] = ac0; sm[i1] = ac1; sm[128 + i0] = e0; sm[128 + i1] = e1;
        sm[256 + i0] = e0 * __expf(tot - ac0); sm[256 + i1] = e1 * __expf(tot - ac1); sm[384 + i0] = __expf(ac0); sm[384 + i1] = __expf(ac1);
    }
    return tot;
}
__device__ __forceinline__ void ssd_write(Frame& F, const SsdLoad& L, bool full, const LAS float* sm) {
    if (full) {
#pragma unroll
        for (int k = 0; k < 4; ++k) { const int q = F.tid + NTHR * k, r = q >> 4, cch = q & 15; *(LAS u32x4*)(F.lds + I_C + img(r, cch)) = L.c[k]; *(LAS u32x4*)(F.lds + I_B + img(r, cch)) = L.b[k]; }
    }
#pragma unroll
    for (int k = 0; k < 4; ++k) { const int q = F.tid + NTHR * k, r = q >> 4, cch = q & 15;
        const f32x4 e0 = *(const LAS f32x4*)(sm + 256 + cch * 8), e1 = *(const LAS f32x4*)(sm + 256 + cch * 8 + 4); const u32x4 v = L.bt[k];
        u32x4 o; o.x = pk2(bflo(v.x) * e0.x, bfhi(v.x) * e0.y); o.y = pk2(bflo(v.y) * e0.z, bfhi(v.y) * e0.w); o.z = pk2(bflo(v.z) * e1.x, bfhi(v.z) * e1.y); o.w = pk2(bflo(v.w) * e1.z, bfhi(v.w) * e1.w);
        *(LAS u32x4*)(F.lds + I_BT + img(r, cch)) = o; }
#pragma unroll
    for (int k = 0; k < 2; ++k) { const int q = F.tid + NTHR * k, r = q >> 4, cch = q & 15; *(LAS u32x4*)(F.lds + I_XT + img(r, cch)) = L.xt[k]; }
}

__device__ __forceinline__ void ssd_item(Frame& F, int item, const bf16_t* Cc, const bf16_t* Bc, const bf16_t* BcT, const bf16_t* XT, const float* dtraw,
                                         const float* dtbf, const float* dtbb, const float* alf, const float* alb, const float* dskip, bf16_t* Yf, bf16_t* Yb) {
    const int dir = item & 1, bh = item >> 1, b = bh / NH, h = bh % NH, g = h >> 3;
    const int fr = F.lane & 15, fq = F.lane >> 4, w = F.wave;
    const float a = -__expf(dir == 0 ? alf[h] : alb[h]), bias = dir == 0 ? dtbf[h] : dtbb[h], dsk = dskip[h];
    bf16_t* Y = dir == 0 ? Yf : Yb;
    LAS float* smb = (LAS float*)(F.lds + SMALL_OFF);
    f32x4 accH[4];
#pragma unroll
    for (int nb = 0; nb < 4; ++nb) accH[nb] = (f32x4){0.f, 0.f, 0.f, 0.f};
    for (int q = F.tid; q < 64 * 16; q += NTHR) *(LAS u32x4*)(F.lds + I_H + q * 16) = (u32x4){0u, 0u, 0u, 0u};
    auto chunk_of = [&](int s, bool& full, int& ck, int& row0) { if (s < 2) { const int c = dir == 0 ? s : 1 - s; full = false; ck = NCHUNK_L + b * 2 + c; row0 = T + b * CTXL + c * CH; }
                                                                  else { const int c = dir == 0 ? s - 2 : 17 - s; full = true; ck = b * NCH + c; row0 = b * SEQ + c * CH; } };
    SsdLoad L; bool full; int ck, row0;
    chunk_of(0, full, ck, row0);
    ssd_issue(F, L, full, ck, row0, g, h, dir, Cc, Bc, BcT, XT, dtraw, bias);
    float tot = ssd_tables(F, L, smb, a, dir);
    __syncthreads();
    for (int s = 0; s < 18; ++s) {
        LAS float* sm = smb + (s & 1) * 512; LAS float* smn = smb + ((s + 1) & 1) * 512;
        const bool cfull = full; const int crow0 = row0;
        ssd_write(F, L, cfull, sm);
        float tot_n = 0.f;
        if (s + 1 < 18) { chunk_of(s + 1, full, ck, row0); ssd_issue(F, L, full, ck, row0, g, h, dir, Cc, Bc, BcT, XT, dtraw, bias); }
        LDS_WAIT(); __syncthreads();
        const LAS unsigned char* lds = F.lds;
        if (cfull) {
            f32x4 gacc[8];
#pragma unroll
            for (int jb = 0; jb < 8; ++jb) gacc[jb] = (f32x4){0.f, 0.f, 0.f, 0.f};
#pragma unroll
            for (int ks = 0; ks < 4; ++ks) { const bf16x8 cf = frag(lds + I_C, 16 * w, ks, fr, fq);
#pragma unroll
                for (int jb = 0; jb < 8; ++jb) gacc[jb] = MFMA16(frag(lds + I_B, 16 * jb, ks, fr, fq), cf, gacc[jb]); }
            const int i = 16 * w + fr; const float aci = sm[i];
            u32x2 mrow[8];
#pragma unroll
            for (int jb = 0; jb < 8; ++jb) { const int j0 = 16 * jb + 4 * fq; const f32x4 acj = *(const LAS f32x4*)(sm + j0), dtj = *(const LAS f32x4*)(sm + 128 + j0);
                float mv[4];
#pragma unroll
                for (int r = 0; r < 4; ++r) { const int j = j0 + r; const bool ok = dir == 0 ? (j <= i) : (j >= i); mv[r] = ok ? gacc[jb][r] * __expf(aci - acj[r]) * dtj[r] : 0.f; }
                mrow[jb].x = pk2(mv[0], mv[1]); mrow[jb].y = pk2(mv[2], mv[3]); }
            LDS_WAIT(); __syncthreads();
#pragma unroll
            for (int jb = 0; jb < 8; ++jb) *(LAS u32x2*)(F.lds + I_B + img(i, 2 * jb + (fq >> 1)) + (fq & 1) * 8) = mrow[jb];
            LDS_WAIT();
            f32x4 yacc[4];
#pragma unroll
            for (int pb = 0; pb < 4; ++pb) yacc[pb] = (f32x4){0.f, 0.f, 0.f, 0.f};
#pragma unroll
            for (int ks = 0; ks < 4; ++ks) { const bf16x8 cf = frag(lds + I_C, 16 * w, ks, fr, fq);
#pragma unroll
                for (int pb = 0; pb < 4; ++pb) yacc[pb] = MFMA16(frag(lds + I_H, 16 * pb, ks, fr, fq), cf, yacc[pb]); }
            const float dai = sm[384 + i];
#pragma unroll
            for (int pb = 0; pb < 4; ++pb) yacc[pb] *= dai;
#pragma unroll
            for (int ks = 0; ks < 4; ++ks) { const bf16x8 mf = frag(lds + I_B, 16 * w, ks, fr, fq);
#pragma unroll
                for (int pb = 0; pb < 4; ++pb) yacc[pb] = MFMA16(frag(lds + I_XT, 16 * pb, ks, fr, fq), mf, yacc[pb]); }
            if (dir == 0) {
#pragma unroll
                for (int pb = 0; pb < 4; ++pb)
#pragma unroll
                    for (int r = 0; r < 4; ++r) { const int p = 16 * pb + 4 * fq + r; const bf16_t xv = *(const LAS bf16_t*)(lds + I_XT + img(p, i >> 3) + (i & 7) * 2); yacc[pb][r] += dsk * bf2f(xv); }
            }
#pragma unroll
            for (int pb = 0; pb < 4; ++pb) { u32x2 o; o.x = pk2(yacc[pb][0], yacc[pb][1]); o.y = pk2(yacc[pb][2], yacc[pb][3]);
                *(GAS u32x2*)(Y + (size_t)(crow0 + i) * 2048 + h * HD + 16 * pb + 4 * fq) = o; }
        }
        const int pbk = w & 3, nh = w >> 2;
        const float et = __expf(tot);
#pragma unroll
        for (int nb = 0; nb < 4; ++nb) accH[nb] *= et;
#pragma unroll
        for (int ks = 0; ks < 4; ++ks) { const bf16x8 xf = frag(lds + I_XT, 16 * pbk, ks, fr, fq);
#pragma unroll
            for (int nb = 0; nb < 4; ++nb) accH[nb] = MFMA16(frag(lds + I_BT, 64 * nh + 16 * nb, ks, fr, fq), xf, accH[nb]); }
        if (s + 1 < 18) tot_n = ssd_tables(F, L, smn, a, dir);
        LDS_WAIT(); __syncthreads();
#pragma unroll
        for (int nb = 0; nb < 4; ++nb) { u32x2 o; o.x = pk2(accH[nb][0], accH[nb][1]); o.y = pk2(accH[nb][2], accH[nb][3]);
            const int p = 16 * pbk + fr, n0 = 64 * nh + 16 * nb + 4 * fq; *(LAS u32x2*)(F.lds + I_H + img(p, n0 >> 3) + (n0 & 7) * 2) = o; }
        tot = tot_n;
    }
    __syncthreads();
}

__device__ __forceinline__ void gmlp_item(Frame& F, int item, const bf16_t* P, const bf16_t* VT, const float* lnstat, const float* lg, const float* lb, const float* ws, const float* bs, bf16_t* mixA) {
    const int ck = item >> 3, g = item & 7, row0 = ck * CH;
    const int fr = F.lane & 15, fq = F.lane >> 4;
    LAS float* sm = (LAS float*)(F.lds + SMALL_OFF);
    constexpr int I_W = 0, I_V = 32768;
    if (F.tid < 128) { const size_t row = (size_t)row0 + F.tid; const float m = lnstat[2 * row] * (1.f / 2048); const float var = lnstat[2 * row + 1] * (1.f / 2048) - m * m; sm[F.tid] = m; sm[128 + F.tid] = rsqrtf(var + EPS); }
#pragma unroll
    for (int k = 0; k < 8; ++k) { const int q = F.tid + NTHR * k, r = q >> 4, cch = q & 15; *(LAS u32x4*)(F.lds + I_V + img(r, cch)) = *(const GAS u32x4*)(VT + ((size_t)ck * 2048 + g * 256) * CH + (size_t)q * 8); }
    __syncthreads();
    { const int i = F.tid >> 2, q4 = F.tid & 3; const float* wr = ws + ((size_t)g * 128 + i) * 128 + q4 * 32; float c1 = 0.f, c2 = 0.f;
#pragma unroll
      for (int k = 0; k < 4; ++k) { const f32x4 wa = *(const GAS f32x4*)(wr + 8 * k), wb = *(const GAS f32x4*)(wr + 8 * k + 4); const int j0 = q4 * 32 + 8 * k;
          const f32x4 ra = *(const LAS f32x4*)(sm + 128 + j0), rb = *(const LAS f32x4*)(sm + 128 + j0 + 4), ma = *(const LAS f32x4*)(sm + j0), mb = *(const LAS f32x4*)(sm + j0 + 4);
          const f32x4 pa = wa * ra, pb = wb * rb;
          c1 += (pa.x * ma.x + pa.y * ma.y) + (pa.z * ma.z + pa.w * ma.w) + (pb.x * mb.x + pb.y * mb.y) + (pb.z * mb.z + pb.w * mb.w);
          c2 += (wa.x + wa.y) + (wa.z + wa.w) + (wb.x + wb.y) + (wb.z + wb.w);
          u32x4 o; o.x = pk2(pa.x, pa.y); o.y = pk2(pa.z, pa.w); o.z = pk2(pb.x, pb.y); o.w = pk2(pb.z, pb.w);
          *(LAS u32x4*)(F.lds + I_W + img(i, q4 * 4 + k)) = o; }
      c1 += __shfl_xor(c1, 1); c1 += __shfl_xor(c1, 2); c2 += __shfl_xor(c2, 1); c2 += __shfl_xor(c2, 2);
      if (q4 == 0) { sm[256 + i] = c1; sm[384 + i] = c2; } }
    LDS_WAIT(); __syncthreads();
    const int wi = F.wave >> 2, wc4 = F.wave & 3;
    f32x4 acc[4][4];
#pragma unroll
    for (int ib = 0; ib < 4; ++ib)
#pragma unroll
        for (int cb = 0; cb < 4; ++cb) acc[ib][cb] = (f32x4){0.f, 0.f, 0.f, 0.f};
#pragma unroll
    for (int ks = 0; ks < 4; ++ks) { bf16x8 wf[4];
#pragma unroll
        for (int ib = 0; ib < 4; ++ib) wf[ib] = frag(F.lds + I_W, 64 * wi + 16 * ib, ks, fr, fq);
#pragma unroll
        for (int cb = 0; cb < 4; ++cb) { const bf16x8 vf = frag(F.lds + I_V, 64 * wc4 + 16 * cb, ks, fr, fq);
#pragma unroll
            for (int ib = 0; ib < 4; ++ib) acc[ib][cb] = MFMA16(vf, wf[ib], acc[ib][cb]); } }
#pragma unroll
    for (int ib = 0; ib < 4; ++ib) { const int i = 64 * wi + 16 * ib + fr; const float c1 = sm[256 + i], c2 = sm[384 + i], bsi = bs[g * 128 + i]; const size_t row = (size_t)row0 + i;
#pragma unroll
        for (int cb = 0; cb < 4; ++cb) { const int ch = g * 256 + 64 * wc4 + 16 * cb + 4 * fq;
            const f32x4 gv = *(const GAS f32x4*)(lg + ch), bv = *(const GAS f32x4*)(lb + ch); const u32x2 uu = *(const GAS u32x2*)(P + row * PW + PC_U + ch);
            const f32x4 s = gv * (acc[ib][cb] - c1) + bv * c2 + bsi;
            u32x2 o; o.x = pk2(bflo(uu.x) * s.x, bfhi(uu.x) * s.y); o.y = pk2(bflo(uu.y) * s.z, bfhi(uu.y) * s.w);
            *(GAS u32x2*)(mixA + row * 4096 + 2048 + ch) = o; } }
    __syncthreads();
}
__global__ void __launch_bounds__(NTHR, 2) mk_fwd(Args args) {
    extern __shared__ __attribute__((aligned(16))) unsigned char lds_raw[];
    Frame F; F.lds = (LAS unsigned char*)lds_raw; F.tid = threadIdx.x; F.lane = F.tid & 63; F.wave = __builtin_amdgcn_readfirstlane(F.tid >> 6); F.G = gridDim.x; F.bid = blockIdx.x;
    unsigned char* ws = args.ws;
    for (int u = F.tid; u < (LDS_BYTES - LDSCTL_OFF) / 4; u += NTHR) ((LAS unsigned*)(F.lds + LDSCTL_OFF))[u] = 0u;
    __syncthreads();
    XcdBarrier bar = xcd_barrier_post((unsigned*)(ws + WS_CTL) + CW_BAR + args.li * XCD_BAR_WORDS, (volatile LAS unsigned*)(F.lds + MISC_OFF) + 8);
    const int lo = args.ph_lo, hi = args.ph_hi;
#define IN(k) (lo <= (k) && (k) < hi)
#define BOTH(k) (IN(k) && IN((k) + 1))
    float* mod = (float*)(ws + WS_CTL + CTL_MOD); float* ssq1 = (float*)(ws + WS_CTL + CTL_SSQ1); int* cnt = (int*)(ws + WS_CTL + CTL_CNT);
    bf16_t* P = (bf16_t*)(ws + WS_P); bf16_t* mixA = (bf16_t*)(ws + WS_MIX); float* x1 = (float*)(ws + WS_X1); bf16_t* h2 = (bf16_t*)(ws + WS_H2);
    int* list = (int*)(ws + WS_LIST); float* wts = (float*)(ws + WS_WTS); bf16_t* Hid = (bf16_t*)(ws + WS_XN); bf16_t* Ymoe = (bf16_t*)(ws + WS_YMOE);
    LAS int* tab = (LAS int*)(F.lds + SMALL_OFF);
    if (IN(0)) { p0_phase(F, args); if (BOTH(0)) xcd_barrier(bar); }
    if (IN(1)) { norm_rows_phase(F, args.in[0], args.in[2], args.in[6], mod, 0, D, (bf16_t*)(ws + WS_XN)); if (BOTH(1)) xcd_barrier(bar); }
    if (IN(2)) {
        pg8::Gemm g{(const bf16_t*)(ws + WS_XN), (const bf16_t*)(ws + WS_WIN), D};
        InOrder S{F.G, F.bid};
        EpiIn E{P, (float*)(ws + WS_DT), (float*)(ws + WS_CTL + CTL_LNST)};
        pg8::gemm_phase<EpiIn, InOrder, false>(F.lds, g, S, E);
        if (BOTH(2)) xcd_barrier(bar);
    }
    if (IN(3)) { p2a_phase(F, P, args.in[8], args.in[9], (bf16_t*)(ws + WS_CC), (bf16_t*)(ws + WS_BC), (bf16_t*)(ws + WS_BCT), (bf16_t*)(ws + WS_XN), (bf16_t*)(ws + WS_VT)); if (BOTH(3)) xcd_barrier(bar); }
    if (IN(4)) {
        for (int it = F.bid; it < BATCH * NH * 2; it += F.G)
            ssd_item(F, it, (const bf16_t*)(ws + WS_CC), (const bf16_t*)(ws + WS_BC), (const bf16_t*)(ws + WS_BCT), (const bf16_t*)(ws + WS_XN), (const float*)(ws + WS_DT),
                     args.in[10], args.in[11], args.in[12], args.in[13], args.in[14], (bf16_t*)(ws + WS_YF), (bf16_t*)(ws + WS_YB));
        for (int it = F.bid; it < NCHUNK_L * 8; it += F.G)
            gmlp_item(F, it, P, (const bf16_t*)(ws + WS_VT), (const float*)(ws + WS_CTL + CTL_LNST), args.in[16], args.in[17], args.in[18], args.in[19], mixA);
        if (BOTH(4)) xcd_barrier(bar);
    }
    if (IN(5)) { finish_phase(F, P, (const bf16_t*)(ws + WS_YF), (const bf16_t*)(ws + WS_YB), args.in[15], mixA); if (BOTH(5)) xcd_barrier(bar); }
    if (IN(6)) {
        pg8::Gemm g{mixA, (const bf16_t*)(ws + WS_WOUT), 2 * D};
        OutOrder S{F.G, F.bid};
        EpiOut E{args.in[0], mod, x1, ssq1};
        pg8::gemm_phase<EpiOut, OutOrder, false>(F.lds, g, S, E);
        if (BOTH(6)) xcd_barrier(bar);
    }
    if (IN(7)) { route_phase(F, x1, ssq1, args.in[21], mod, (const float*)(ws + WS_WRT), args.in[23], args.in[25], h2, cnt, list, wts); if (BOTH(7)) xcd_barrier(bar); }
    if (IN(8)) {
        moe_table(F, cnt, tab);
        pg8::Gemm g{h2, (const bf16_t*)(ws + WS_WGU), D};
        MoeOrder<4> S{F.G, F.bid, tab, list};
        EpiGU E{Hid, tab, list, wts};
        pg8::gemm_phase<EpiGU, MoeOrder<4>, true>(F.lds, g, S, E);
        if (BOTH(8)) xcd_barrier(bar);
    }
    if (IN(9)) {
        moe_table(F, cnt, tab);
        pg8::Gemm g{Hid, (const bf16_t*)(ws + WS_WD), FF};
        MoeOrder<8> S{F.G, F.bid, tab, list};
        EpiDown E{Ymoe, tab, list};
        pg8::gemm_phase<EpiDown, MoeOrder<8>, false>(F.lds, g, S, E);
        if (BOTH(9)) xcd_barrier(bar);
    }
    if (IN(10)) { final_phase(F, x1, Ymoe, mod, args.in[29], args.out); }
#undef IN
#undef BOTH
}
extern "C" void kernel_launch(void* const* d_in, const int* in_sizes, int n_in, void* d_out, int out_size, void* d_ws, size_t ws_size, hipStream_t stream) {
    static int grid = 0;
    if (grid == 0) {
        if (n_in != 30 || ws_size < WS_END) { fprintf(stderr, "kernel_launch: bad n_in %d or ws %zu < %zu\n", n_in, ws_size, (size_t)WS_END); grid = -1; return; }
        int dev = 0, cus = 0, per_cu = 0;
        if (hipGetDevice(&dev) != hipSuccess || hipDeviceGetAttribute(&cus, hipDeviceAttributeMultiprocessorCount, dev) != hipSuccess) { grid = -1; return; }
        if (hipFuncSetAttribute((const void*)mk_fwd, hipFuncAttributeMaxDynamicSharedMemorySize, LDS_BYTES) != hipSuccess) { fprintf(stderr, "hipFuncSetAttribute failed\n"); grid = -1; return; }
        if (hipOccupancyMaxActiveBlocksPerMultiprocessor(&per_cu, (const void*)mk_fwd, NTHR, LDS_BYTES) != hipSuccess || per_cu < 1) { fprintf(stderr, "occupancy query says %d\n", per_cu); per_cu = 1; }
        (void)hipGetLastError();
        grid = cus;
    }
    if (grid < 0) return;
    unsigned char* ws = (unsigned char*)d_ws;
    hipMemsetAsync(ws + WS_CTL, 0, CTL_BYTES, stream);
    Args a{};
    for (int i = 0; i < 30; ++i) a.in[i] = (const float*)d_in[i];
    a.out = (float*)d_out; a.ws = ws;
    auto run = [&](int lo, int hi) { a.ph_lo = lo; a.ph_hi = hi; a.li = 0; hipLaunchKernelGGL(mk_fwd, dim3(grid), dim3(NTHR), LDS_BYTES, stream, a); };
    run(0, 11);
}
```
